# Optimizing an MI355X kernel written in HIP

```python
import math, functools
import jax, jax.numpy as jnp
from jax import lax
import numpy as np

D_MODEL = 1024
BATCH = 8
SEQ = 2048
DEPTH = 1
DEC_BATCH = 128
DEC_SEQ = 1
PAST_LEN = 16384
PAGE_SIZE = 128

N_META = 16
MIX_WIDTH = D_MODEL
CONV_CH = MIX_WIDTH // 2
CONV_WIDTH = 3
RET_HEADS = 4
QK_DIM = (MIX_WIDTH // 2) // RET_HEADS
V_DIM = (MIX_WIDTH // 2) // RET_HEADS
RET_WIDTH = RET_HEADS * V_DIM
CHUNK = 128
D_FF = 4 * D_MODEL
ROPE_BASE = 10000.0
EPS = 1e-6
IN_WIDTHS = (CONV_CH, CONV_CH, CONV_CH, RET_HEADS * QK_DIM, RET_HEADS * QK_DIM, RET_WIDTH, RET_WIDTH)
IN_TOTAL = sum(IN_WIDTHS)
SPLITS = tuple(int(s) for s in np.cumsum(IN_WIDTHS)[:-1])

kernel_name = "hymba_conv_retention_decode_step"


def rmsnorm(x, g):
    xf = x.astype(jnp.float32)
    y = xf * lax.rsqrt(jnp.mean(xf * xf, axis=-1, keepdims=True) + EPS)
    return (y * g.astype(jnp.float32)).astype(x.dtype)


def head_rmsnorm(o):
    of = o.astype(jnp.float32)
    y = of * lax.rsqrt(jnp.mean(of * of, axis=-1, keepdims=True) + EPS)
    return y.astype(o.dtype)


def rotary(x, pos):
    dh = x.shape[-1]
    inv_freq = 1.0 / (ROPE_BASE ** (jnp.arange(0, dh, 2, dtype=jnp.float32) / dh))
    ang = pos[:, None] * inv_freq[None, :]
    cos = jnp.cos(ang)[None, :, None, :].astype(x.dtype)
    sin = jnp.sin(ang)[None, :, None, :].astype(x.dtype)
    x1, x2 = jnp.split(x, 2, axis=-1)
    return jnp.concatenate([x1 * cos - x2 * sin, x1 * sin + x2 * cos], axis=-1)


def causal_conv3(u_prev, u, w):
    full = jnp.concatenate([u_prev.astype(u.dtype), u], axis=1)
    y = w[0] * full[:, :-2] + w[1] * full[:, 1:-1] + w[2] * full[:, 2:]
    return y, full[:, -(CONV_WIDTH - 1):]


def retention_block(q, k, v, s_prev, log_gamma):
    L = q.shape[1]
    idx = jnp.arange(L, dtype=jnp.float32)
    diff = idx[:, None] - idx[None, :]
    decay = jnp.where(diff >= 0,
                      jnp.exp(log_gamma[:, None, None] * jnp.maximum(diff, 0.0)),
                      0.0).astype(q.dtype)
    scores = jnp.einsum('bihd,bjhd->bhij', q, k) * decay
    inner = jnp.einsum('bhij,bjhe->bihe', scores, v)
    q_decay = jnp.exp((idx[:, None] + 1.0) * log_gamma[None, :]).astype(q.dtype)
    cross = jnp.einsum('bihd,bhde->bihe', q, s_prev) * q_decay[None, :, :, None]
    k_decay = jnp.exp((L - 1.0 - idx)[:, None] * log_gamma[None, :]).astype(q.dtype)
    s_new = (s_prev * jnp.exp(L * log_gamma).astype(q.dtype)[None, :, None, None]
             + jnp.einsum('bjhd,bjhe->bhde', k * k_decay[None, :, :, None], v))
    return inner + cross, s_new


def retention_prompt(q, k, v, s_prev, log_gamma):
    o_meta, s = retention_block(q[:, :N_META], k[:, :N_META], v[:, :N_META], s_prev, log_gamma)
    Bsz, T, H, dk = q.shape
    n_chunks = (T - N_META) // CHUNK

    def to_chunks(a):
        a = a[:, N_META:].reshape(Bsz, n_chunks, CHUNK, H, a.shape[-1])
        return jnp.moveaxis(a, 1, 0)

    def step(s_c, blk):
        qc, kc, vc = blk
        o_c, s_n = retention_block(qc, kc, vc, s_c, log_gamma)
        return s_n, o_c

    s_final, o_chunks = lax.scan(step, s, (to_chunks(q), to_chunks(k), to_chunks(v)))
    o_real = jnp.moveaxis(o_chunks, 0, 1).reshape(Bsz, n_chunks * CHUNK, H, v.shape[-1])
    return jnp.concatenate([o_meta, o_real], axis=1), s_final


def layer(h, pos, conv_prev, ret_prev, norm_mix, w_in, conv_w, w_out,
          norm_mlp, w_up, w_down, ret_fn):
    Bsz, T, _ = h.shape
    hn = rmsnorm(h, norm_mix)
    z = hn @ w_in
    u_in, c_gate, b_gate, q, k, v, g = jnp.split(z, SPLITS, axis=-1)
    conv_y, conv_state = causal_conv3(conv_prev, c_gate * u_in, conv_w)
    y_conv = b_gate * conv_y
    q = rotary(q.reshape(Bsz, T, RET_HEADS, QK_DIM), pos)
    k = rotary(k.reshape(Bsz, T, RET_HEADS, QK_DIM), pos) * (QK_DIM ** -0.5)
    v = v.reshape(Bsz, T, RET_HEADS, V_DIM)
    o, ret_state = ret_fn(q, k, v, ret_prev.astype(q.dtype))
    y_ret = head_rmsnorm(o).reshape(Bsz, T, RET_WIDTH) * jax.nn.silu(g)
    h = h + jnp.concatenate([y_conv, y_ret], axis=-1) @ w_out
    hn2 = rmsnorm(h, norm_mlp)
    h = h + jnp.square(jax.nn.relu(hn2 @ w_up)) @ w_down
    return h, conv_state, ret_state


def setup_inputs(seed: int = 0) -> dict:
    key = jax.random.key(seed)
    ks = jax.random.split(key, 16)
    f32 = jnp.float32
    return {
        "x_prompt": jax.random.normal(ks[0], (BATCH, SEQ, D_MODEL), f32),
        "x_sample": jax.random.normal(ks[1], (DEC_BATCH, DEC_SEQ, D_MODEL), f32),
        "cache_conv": jax.random.normal(ks[2], (DEPTH, DEC_BATCH, CONV_WIDTH - 1, CONV_CH), f32),
        "state_ret": 0.5 * jax.random.normal(ks[3], (DEPTH, DEC_BATCH, RET_HEADS, QK_DIM, V_DIM), f32),
        "meta_tokens": jax.random.normal(ks[4], (N_META, D_MODEL), f32),
        "norm_mix": 1.0 + 0.02 * jax.random.normal(ks[5], (DEPTH, D_MODEL), f32),
        "w_in": jax.random.normal(ks[6], (DEPTH, D_MODEL, IN_TOTAL), f32) * D_MODEL ** -0.5,
        "conv_w": jax.random.normal(ks[7], (DEPTH, CONV_WIDTH, CONV_CH), f32) * CONV_WIDTH ** -0.5,
        "w_out": jax.random.normal(ks[8], (DEPTH, MIX_WIDTH, D_MODEL), f32) * MIX_WIDTH ** -0.5,
        "norm_mlp": 1.0 + 0.02 * jax.random.normal(ks[9], (DEPTH, D_MODEL), f32),
        "w_up": jax.random.normal(ks[10], (DEPTH, D_MODEL, D_FF), f32) * D_MODEL ** -0.5,
        "w_down": jax.random.normal(ks[11], (DEPTH, D_FF, D_MODEL), f32) * D_FF ** -0.5,
        "norm_final": 1.0 + 0.02 * jax.random.normal(ks[12], (D_MODEL,), f32),
    }


def reference(x_prompt, x_sample, cache_conv, state_ret, meta_tokens, norm_mix, w_in,
              conv_w, w_out, norm_mlp, w_up, w_down, norm_final):
    log_gamma = jnp.log(1.0 - 2.0 ** (-5.0 - jnp.arange(RET_HEADS, dtype=jnp.float32)))
    ret_prompt_fn = functools.partial(retention_prompt, log_gamma=log_gamma)
    ret_sample_fn = functools.partial(retention_block, log_gamma=log_gamma)

    meta = jnp.broadcast_to(meta_tokens.astype(x_prompt.dtype)[None], (BATCH, N_META, D_MODEL))
    hp = jnp.concatenate([meta, x_prompt], axis=1)
    pos_p = jnp.arange(SEQ + N_META, dtype=jnp.float32)
    hs = x_sample
    pos_s = PAST_LEN + jnp.arange(DEC_SEQ, dtype=jnp.float32)

    conv_zero = jnp.zeros((BATCH, CONV_WIDTH - 1, CONV_CH), x_prompt.dtype)
    ret_zero = jnp.zeros((BATCH, RET_HEADS, QK_DIM, V_DIM), x_prompt.dtype)
    conv_p_list, ret_p_list, conv_s_list, ret_s_list = [], [], [], []
    for l in range(DEPTH):
        hp, cp, rp = layer(hp, pos_p, conv_zero, ret_zero, norm_mix[l], w_in[l], conv_w[l],
                           w_out[l], norm_mlp[l], w_up[l], w_down[l], ret_prompt_fn)
        hs, cs, rs = layer(hs, pos_s, cache_conv[l], state_ret[l], norm_mix[l], w_in[l], conv_w[l],
                           w_out[l], norm_mlp[l], w_up[l], w_down[l], ret_sample_fn)
        conv_p_list.append(cp); ret_p_list.append(rp)
        conv_s_list.append(cs); ret_s_list.append(rs)

    y_prompt = rmsnorm(hp, norm_final)[:, N_META:]
    y_sample = rmsnorm(hs, norm_final)
    new_conv_prompt = jnp.stack(conv_p_list)
    new_ret_prompt = jnp.stack(ret_p_list)
    new_conv_sample = jnp.stack(conv_s_list)
    new_ret_sample = jnp.stack(ret_s_list)
    return (y_prompt, y_sample, new_conv_prompt, new_ret_prompt, new_conv_sample, new_ret_sample)
```

```cpp
#include <hip/hip_runtime.h>
#include <hip/hip_cooperative_groups.h>
#include <cstdio>
#include <cstdint>
namespace cg = cooperative_groups;
namespace pg8 {
#define PG8_LAS __attribute__((address_space(3)))
typedef unsigned short bf16_t;
typedef short bf16x8 __attribute__((ext_vector_type(8)));
typedef float f32x4 __attribute__((ext_vector_type(4)));
typedef unsigned u32x4 __attribute__((ext_vector_type(4)));
constexpr int BM = 256, BK = 64, HALF = 128, HTB = HALF * BK * 2  , STAGE_BYTES = 8 * HTB, NXCD = 8, WGM = 8;

__host__ __device__ __forceinline__ int lds_byte(int r, int c) { const int st = (r >> 4) * 2 + (c >> 5), rr = r & 15, cc = c & 31, ob = rr * 64 + cc * 2; return st * 1024 + (ob ^ (((ob >> 9) & 1) << 5)); }
__host__ __device__ __forceinline__ void stage_rc(int b, int& R, int& C) { const int st = b / 1024, sb = b % 1024, swz = sb ^ (((sb >> 9) & 1) << 5); R = (st >> 1) * 16 + swz / 64; C = (st & 1) * 32 + (swz % 64) / 2; }
__host__ __device__ __forceinline__ int perm32(int rho) { const int n = rho >> 4, i = rho & 15; return 8 * (i >> 2) + 4 * n + (i & 3); }

struct Unit { int pm, pn; };
struct Gemm { const bf16_t* A; const bf16_t* Bt; int M, N, K; };

struct StaticOrder {
    int nM, nN, nwg, G, c;
    __host__ __device__ void init(int M, int N, int G_, int c_) { nM = M / BM; nN = N / BM; nwg = nM * nN; G = G_; c = c_; }
    __host__ __device__ bool next(int i, Unit& u) const {
        const long L = (long)i * G + c; if (L >= nwg) return false;
        int wgid = (int)L; { const int q = nwg / NXCD, r = nwg % NXCD, xcd = wgid % NXCD, off = wgid / NXCD; wgid = (xcd < r ? xcd * (q + 1) : r * (q + 1) + (xcd - r) * q) + off; }
        const int nig = WGM * nN, gid = wgid / nig, fm = gid * WGM, gsz = (nM - fm) < WGM ? (nM - fm) : WGM;
        u.pm = fm + ((wgid % nig) % gsz); u.pn = (wgid % nig) / gsz; return true;
    }
    __device__ __forceinline__ void a_ready(const Unit&) const {}
    __device__ __forceinline__ void done(const Unit&) const {}
};
__device__ __forceinline__ unsigned cvt_pk_bf16(float lo, float hi) { unsigned r; asm volatile("v_cvt_pk_bf16_f32 %0, %1, %2" : "=v"(r) : "v"(lo), "v"(hi)); return r; }
typedef float f32x2 __attribute__((ext_vector_type(2)));
template <class Epi, class Sched, bool ALIGN_EPI = false, bool SP2 = false>
__device__ __forceinline__ void gemm_phase(PG8_LAS unsigned char* lds, const Gemm g, const Sched& S, const Epi& E) {
    const int tid = threadIdx.x, wid = __builtin_amdgcn_readfirstlane(tid >> 6), lane = tid & 63, wr = wid >> 2, wc = wid & 3, fr = lane & 15, fq = lane >> 4;
    const int K = g.K, nt = K / BK;
    unsigned voffA[2], voffB[2];
#pragma unroll
    for (int i = 0; i < 2; ++i) { int R, C; stage_rc(tid * 16 + i * 8192, R, C); const int Rb = Epi::PERM ? ((R & ~31) + perm32(R & 31)) : R;
        voffA[i] = (unsigned)(R * K + C) * 2u; voffB[i] = (unsigned)(Rb * K + C) * 2u; }
    const size_t kstep = (size_t)(BK * 2);
    const size_t hstep = (size_t)HALF * K * 2;
    const size_t tstep = 2 * hstep;
    const unsigned ldsw = (unsigned)wid * 1024u;
    const int aoff = lds_byte(wr * 64 + fr, fq * 8), boff = lds_byte(wc * 32 + fr, fq * 8);
#define PG8_SA(b, h) (((b) * 2 + (h)) * HTB)
#define PG8_SB(b, h) ((4 + (b) * 2 + (h)) * HTB)
#define PG8_STAGE(bufoff, gbase, voff) do { _Pragma("unroll") for (int _i = 0; _i < 2; ++_i) \
        __builtin_amdgcn_global_load_lds((const unsigned*)((const char*)(gbase) + (voff)[_i]), (PG8_LAS unsigned*)(lds + (bufoff) + ldsw + _i * 8192), 16, 0, 0); } while (0)
#define PG8_LDA(dst, b, h) do { _Pragma("unroll") for (int m = 0; m < 4; ++m) _Pragma("unroll") for (int k = 0; k < 2; ++k) dst[m][k] = *(const PG8_LAS bf16x8*)(lds + PG8_SA(b, h) + aoff + m * 2048 + k * 1024); } while (0)
#define PG8_LDB(dst, b, h) do { _Pragma("unroll") for (int n = 0; n < 2; ++n) _Pragma("unroll") for (int k = 0; k < 2; ++k) dst[n][k] = *(const PG8_LAS bf16x8*)(lds + PG8_SB(b, h) + boff + n * 2048 + k * 1024); } while (0)
#define PG8_MMA(ai, bj, At, Bt) do { __builtin_amdgcn_s_setprio(1); _Pragma("unroll") for (int m = 0; m < 4; ++m) _Pragma("unroll") for (int n = 0; n < 2; ++n) _Pragma("unroll") for (int k = 0; k < 2; ++k) \
        acc[ai][bj][m][n] = __builtin_amdgcn_mfma_f32_16x16x32_bf16(Bt[n][k], At[m][k], acc[ai][bj][m][n], 0, 0, 0); __builtin_amdgcn_s_setprio(0); } while (0)
#define PG8_WAIT_V(n) asm volatile("s_waitcnt vmcnt(" #n ")" ::: "memory")
#define PG8_WAIT_L(n) asm volatile("s_waitcnt lgkmcnt(" #n ")" ::: "memory")
#define PG8_BAR __builtin_amdgcn_s_barrier()
#define PG8_SCHED __builtin_amdgcn_sched_barrier(0)
    Unit cur, nxt; int ui = 0;
    if (!S.next(0, cur)) return;
    f32x4 acc[2][2][4][2];
#pragma unroll
    for (int a = 0; a < 2; ++a)
#pragma unroll
        for (int b = 0; b < 2; ++b)
#pragma unroll
            for (int m = 0; m < 4; ++m)
#pragma unroll
                for (int n = 0; n < 2; ++n) acc[a][b][m][n] = (f32x4){0.f, 0.f, 0.f, 0.f};
    bf16x8 At[4][2], B0[2][2], B1[2][2];
    const char* cA = (const char*)g.A + (size_t)cur.pm * tstep; const char* cB = (const char*)g.Bt + (size_t)cur.pn * tstep;
    S.a_ready(cur);
    if constexpr (SP2) {
        PG8_STAGE(PG8_SB(0, 0), cB, voffB); PG8_STAGE(PG8_SB(0, 1), cB + hstep, voffB); PG8_STAGE(PG8_SA(0, 0), cA, voffA); PG8_STAGE(PG8_SA(0, 1), cA + hstep, voffA);
        if (wr == 1) PG8_BAR;
        PG8_WAIT_V(2); PG8_BAR;
        PG8_STAGE(PG8_SB(1, 0), cB + kstep, voffB); PG8_STAGE(PG8_SA(1, 0), cA + kstep, voffA); PG8_STAGE(PG8_SB(1, 1), cB + hstep + kstep, voffB);
        PG8_WAIT_V(6); PG8_BAR;
    } else {
        PG8_STAGE(PG8_SB(0, 0), cB, voffB); PG8_STAGE(PG8_SA(0, 0), cA, voffA); PG8_STAGE(PG8_SB(0, 1), cB + hstep, voffB); PG8_STAGE(PG8_SA(0, 1), cA + hstep, voffA);
        if (wr == 1) PG8_BAR;
        PG8_WAIT_V(4); PG8_BAR;
        PG8_STAGE(PG8_SB(1, 0), cB + kstep, voffB); PG8_STAGE(PG8_SA(1, 0), cA + kstep, voffA); PG8_STAGE(PG8_SB(1, 1), cB + hstep + kstep, voffB);
        PG8_WAIT_V(6); PG8_BAR;
    }
    for (;;) {
        const bool has_next = S.next(ui + 1, nxt);
        const char* nA = has_next ? (const char*)g.A + (size_t)nxt.pm * tstep : cA; const char* nB = has_next ? (const char*)g.Bt + (size_t)nxt.pn * tstep : cB;
        for (int t = 0; t < nt; t += 2) {
            const bool last = (t == nt - 2);
            const char* a1 = cA + (size_t)(t + 1) * kstep;
            const char* a2 = last ? nA : cA + (size_t)(t + 2) * kstep; const char* b2 = last ? nB : cB + (size_t)(t + 2) * kstep;
            const char* a3 = a2 + kstep; const char* b3 = b2 + kstep;
            if (last && has_next) S.a_ready(nxt);
            if constexpr (SP2) {
            PG8_LDB(B0, 0, 0); PG8_LDB(B1, 0, 1); PG8_SCHED; PG8_LDA(At, 0, 0); PG8_STAGE(PG8_SA(1, 1), a1 + hstep, voffA);
            PG8_WAIT_V(8); PG8_WAIT_L(0); PG8_BAR; PG8_MMA(0, 0, At, B0); PG8_MMA(0, 1, At, B1); PG8_BAR; PG8_SCHED;
            PG8_LDA(At, 0, 1); PG8_STAGE(PG8_SB(0, 0), b2, voffB); PG8_STAGE(PG8_SB(0, 1), b2 + hstep, voffB); PG8_STAGE(PG8_SA(0, 0), a2, voffA);
            PG8_WAIT_V(8); PG8_WAIT_L(0); PG8_BAR; PG8_MMA(1, 0, At, B0); PG8_MMA(1, 1, At, B1); PG8_BAR; PG8_SCHED;
            PG8_LDB(B0, 1, 0); PG8_LDB(B1, 1, 1); PG8_SCHED; PG8_LDA(At, 1, 0); PG8_STAGE(PG8_SA(0, 1), a2 + hstep, voffA);
            PG8_WAIT_V(8); PG8_WAIT_L(0); PG8_BAR; PG8_MMA(0, 0, At, B0); PG8_MMA(0, 1, At, B1); PG8_BAR; PG8_SCHED;
            PG8_LDA(At, 1, 1); PG8_STAGE(PG8_SB(1, 0), b3, voffB); PG8_STAGE(PG8_SB(1, 1), b3 + hstep, voffB); PG8_STAGE(PG8_SA(1, 0), a3, voffA);
            PG8_WAIT_V(8); PG8_WAIT_L(0); PG8_BAR; PG8_MMA(1, 0, At, B0); PG8_MMA(1, 1, At, B1); PG8_BAR; PG8_SCHED;
            } else {
            PG8_LDB(B0, 0, 0); PG8_SCHED; PG8_LDA(At, 0, 0); PG8_STAGE(PG8_SA(1, 1), a1 + hstep, voffA);
            PG8_WAIT_L(8); PG8_BAR; PG8_WAIT_L(0); PG8_MMA(0, 0, At, B0); PG8_BAR; PG8_SCHED;
            PG8_LDB(B1, 0, 1); PG8_STAGE(PG8_SB(0, 0), b2, voffB);
            PG8_BAR; PG8_WAIT_L(0); PG8_MMA(0, 1, At, B1); PG8_BAR;
            PG8_LDA(At, 0, 1); PG8_STAGE(PG8_SA(0, 0), a2, voffA);
            PG8_BAR; PG8_WAIT_L(0); PG8_MMA(1, 0, At, B0); PG8_BAR; PG8_SCHED;
            PG8_STAGE(PG8_SB(0, 1), b2 + hstep, voffB);
            PG8_WAIT_V(6); PG8_BAR; PG8_MMA(1, 1, At, B1); PG8_BAR;
            PG8_LDB(B0, 1, 0); PG8_SCHED; PG8_LDA(At, 1, 0); PG8_STAGE(PG8_SA(0, 1), a2 + hstep, voffA);
            PG8_WAIT_L(8); PG8_BAR; PG8_WAIT_L(0); PG8_MMA(0, 0, At, B0); PG8_BAR; PG8_SCHED;
            PG8_LDB(B1, 1, 1); PG8_STAGE(PG8_SB(1, 0), b3, voffB);
            PG8_BAR; PG8_WAIT_L(0); PG8_MMA(0, 1, At, B1); PG8_BAR;
            PG8_LDA(At, 1, 1); PG8_STAGE(PG8_SA(1, 0), a3, voffA);
            PG8_BAR; PG8_WAIT_L(0); PG8_MMA(1, 0, At, B0); PG8_BAR; PG8_SCHED;
            PG8_STAGE(PG8_SB(1, 1), b3 + hstep, voffB);
            PG8_WAIT_V(6); PG8_BAR; PG8_MMA(1, 1, At, B1); PG8_BAR;
            }
        }
        if constexpr (ALIGN_EPI) { if (wr == 0) PG8_BAR; }
        if constexpr (!Epi::AFTER_DRAIN) { E(acc, cur, wr, wc, fr, fq); S.done(cur); }
        if (!has_next) break;
#pragma unroll
        for (int a = 0; a < 2; ++a)
#pragma unroll
            for (int b = 0; b < 2; ++b)
#pragma unroll
                for (int m = 0; m < 4; ++m)
#pragma unroll
                    for (int n = 0; n < 2; ++n) acc[a][b][m][n] = (f32x4){0.f, 0.f, 0.f, 0.f};
        cur = nxt; cA = nA; cB = nB; ++ui;
        if constexpr (ALIGN_EPI) { if (wr == 1) PG8_BAR; }
    }
    PG8_WAIT_V(0);
    if constexpr (!ALIGN_EPI) { if (wr == 0) PG8_BAR; }
    PG8_BAR;
    if constexpr (Epi::AFTER_DRAIN) { E.fused(acc, cur, wr, wc, fr, fq, lds, wid, lane); S.done(cur); }
#undef PG8_SA
#undef PG8_SB
#undef PG8_STAGE
#undef PG8_LDA
#undef PG8_LDB
#undef PG8_MMA
#undef PG8_WAIT_V
#undef PG8_WAIT_L
#undef PG8_BAR
#undef PG8_SCHED
}
}

#ifndef PG8_SP2
#define PG8_SP2 true
#endif
#define LAS __attribute__((address_space(3)))
typedef unsigned short bf16;
typedef unsigned u32x4 __attribute__((ext_vector_type(4)));
typedef unsigned u32x2 __attribute__((ext_vector_type(2)));
typedef float f32x4 __attribute__((ext_vector_type(4)));
typedef short bf16x8 __attribute__((ext_vector_type(8)));

constexpr int DM = 1024, NB = 8, SEQ = 2048, NSAMP = 128, NH = 4, HD = 128, INW = 3584, FF = 4096, NCH = 16;
constexpr int MP = NB * SEQ;
constexpr int ROW_S = MP;
constexpr int ROW_M = MP + NSAMP;
constexpr int MV = MP + NSAMP;
constexpr int MPAD = 16640;
constexpr int ZC_U = 0, ZC_C = 512, ZC_B = 1024, ZC_Q = 1536, ZC_K = 2048, ZC_V = 2560, ZC_G = 3072;
constexpr float EPS = 1e-6f;
constexpr int NPOS = 2065;
constexpr size_t O_YP = 0, O_YS = 16777216, O_CP = 16908288, O_RP = 16916480, O_CS = 17440768, O_RS = 17571840;
constexpr size_t MiB = 1u << 20;
constexpr size_t WS_PART1 = 0, WS_PART2 = 3 * MiB / 2;
constexpr size_t WS_W1 = 3 * MiB, WS_W2 = 10 * MiB, WS_W3 = 12 * MiB, WS_W4 = 20 * MiB;
constexpr size_t WS_XN = 28 * MiB, WS_ST = WS_XN, WS_H1B = WS_XN;
constexpr size_t WS_Z = 61 * MiB, WS_YMIX = 175 * MiB, WS_HID = WS_Z;
constexpr size_t WS_KV = 208 * MiB, WS_KVM = 240 * MiB, WS_COS = 241 * MiB, WS_SIN = 242 * MiB, WS_HIDS = 243 * MiB, WS_PARTS1 = 244 * MiB, WS_PARTS2 = 244 * MiB + 65536, WS_END = 245 * MiB;
constexpr int RING_BYTES = 131072, LDS_BYTES = 147456;

__device__ const double INVF[64] = {
1.00000000000000000e+00, 8.65964323360065347e-01, 7.49894209332455763e-01, 6.49381631576211316e-01,
5.62341325190349073e-01, 4.86967525165863058e-01, 4.21696503428582226e-01, 3.65174127254837666e-01,
3.16227766016837886e-01, 2.73841963426436075e-01, 2.37137370566165462e-01, 2.05352502645714585e-01,
1.77827941003892265e-01, 1.53992652605949160e-01, 1.33352143216332403e-01, 1.15478198468945775e-01,
9.99999999999999778e-02, 8.65964323360065291e-02, 7.49894209332455514e-02, 6.49381631576211177e-02,
5.62341325190348837e-02, 4.86967525165862974e-02, 4.21696503428582170e-02, 3.65174127254837555e-02,
3.16227766016837844e-02, 2.73841963426436075e-02, 2.37137370566165399e-02, 2.05352502645714530e-02,
1.77827941003892258e-02, 1.53992652605949125e-02, 1.33352143216332302e-02, 1.15478198468945796e-02,
9.99999999999999500e-03, 8.65964323360064736e-03, 7.49894209332455704e-03, 6.49381631576211038e-03,
5.62341325190348663e-03, 4.86967525165863096e-03, 4.21696503428582118e-03, 3.65174127254837451e-03,
3.16227766016837636e-03, 2.73841963426436040e-03, 2.37137370566165365e-03, 2.05352502645714426e-03,
1.77827941003892210e-03, 1.53992652605949095e-03, 1.33352143216332276e-03, 1.15478198468945770e-03,
9.99999999999999370e-04, 8.65964323360064519e-04, 7.49894209332455531e-04, 6.49381631576210908e-04,
5.62341325190348555e-04, 4.86967525165862933e-04, 4.21696503428581966e-04, 3.65174127254837375e-04,
3.16227766016837831e-04, 2.73841963426435726e-04, 2.37137370566165321e-04, 2.05352502645714556e-04,
1.77827941003892026e-04, 1.53992652605949057e-04, 1.33352143216332368e-04, 1.15478198468945645e-04};

__device__ __forceinline__ unsigned f2bf(float f) { unsigned u = __builtin_bit_cast(unsigned, f); return (u + 0x7fffu + ((u >> 16) & 1u)) >> 16; }
__device__ __forceinline__ unsigned pk2(float lo, float hi) { return pg8::cvt_pk_bf16(lo, hi); }
__device__ __forceinline__ float bflo(unsigned w) { return __builtin_bit_cast(float, w << 16); }
__device__ __forceinline__ float bfhi(unsigned w) { return __builtin_bit_cast(float, w & 0xffff0000u); }
__device__ __forceinline__ float bf2f(bf16 b) { return __builtin_bit_cast(float, (unsigned)b << 16); }
__device__ __forceinline__ float wave_sum(float v) {
#pragma unroll
    for (int o = 1; o < 64; o <<= 1) v += __shfl_xor(v, o);
    return v;
}
__device__ __forceinline__ float log_gamma(int h) { return h == 0 ? -3.17486983145802981e-02f : h == 1 ? -1.57483569681391676e-02f : h == 2 ? -7.84317746102589260e-03f : -3.91389932113632866e-03f; }
#define LDS_WAIT() asm volatile("s_waitcnt lgkmcnt(0)" ::: "memory")

struct EpiZ {
    static constexpr bool PERM = true, AFTER_DRAIN = false;
    bf16* O; int ldc;
    __device__ __forceinline__ void operator()(const f32x4 (&acc)[2][2][4][2], const pg8::Unit& u, int wr, int wc, int fr, int fq) const {
        const int row0 = u.pm * 256 + wr * 64 + fr, col0 = u.pn * 256 + wc * 32 + 8 * fq;
#pragma unroll
        for (int ai = 0; ai < 2; ++ai)
#pragma unroll
            for (int m = 0; m < 4; ++m) { bf16* rowp = O + (size_t)(row0 + ai * 128 + m * 16) * ldc + col0;
#pragma unroll
                for (int bj = 0; bj < 2; ++bj) { const f32x4 v0 = acc[ai][bj][m][0], v1 = acc[ai][bj][m][1];
                    u32x4 w; w.x = pk2(v0[0], v0[1]); w.y = pk2(v0[2], v0[3]); w.z = pk2(v1[0], v1[1]); w.w = pk2(v1[2], v1[3]);
                    *(u32x4*)(rowp + bj * 128) = w; } }
    }
};
struct EpiUp {
    static constexpr bool PERM = true, AFTER_DRAIN = false;
    bf16* O; int ldc; const LAS float* rs; mutable int ord;
    __device__ __forceinline__ void operator()(const f32x4 (&acc)[2][2][4][2], const pg8::Unit& u, int wr, int wc, int fr, int fq) const {
        const int row0 = u.pm * 256 + wr * 64 + fr, col0 = u.pn * 256 + wc * 32 + 8 * fq;
        const LAS float* rt = rs + ord * 256 + wr * 64 + fr;
#pragma unroll
        for (int ai = 0; ai < 2; ++ai)
#pragma unroll
            for (int m = 0; m < 4; ++m) { bf16* rowp = O + (size_t)(row0 + ai * 128 + m * 16) * ldc + col0; const float r = rt[ai * 128 + m * 16];
#pragma unroll
                for (int bj = 0; bj < 2; ++bj) { f32x4 v0 = acc[ai][bj][m][0] * r, v1 = acc[ai][bj][m][1] * r;
#pragma unroll
                    for (int k = 0; k < 4; ++k) { const float a0 = fmaxf(v0[k], 0.f), a1 = fmaxf(v1[k], 0.f); v0[k] = a0 * a0; v1[k] = a1 * a1; }
                    u32x4 w; w.x = pk2(v0[0], v0[1]); w.y = pk2(v0[2], v0[3]); w.z = pk2(v1[0], v1[1]); w.w = pk2(v1[2], v1[3]);
                    *(u32x4*)(rowp + bj * 128) = w; } }
        ord = ord + 1;
    }
};
struct EpiRes {
    static constexpr bool PERM = false, AFTER_DRAIN = false;
    const float* res; const float* res2; float* out; bf16* hb; float* part;
    __device__ __forceinline__ void operator()(const f32x4 (&acc)[2][2][4][2], const pg8::Unit& u, int wr, int wc, int fr, int fq) const {
        const int row0 = u.pm * 256 + wr * 64 + fr, col0 = u.pn * 256 + wc * 32 + 4 * fq;
#pragma unroll
        for (int ai = 0; ai < 2; ++ai)
#pragma unroll
            for (int m = 0; m < 4; ++m) { const int row = row0 + ai * 128 + m * 16; const size_t off = (size_t)row * DM + col0; float ss = 0.f;
                const float* rp = res + off;
#pragma unroll
                for (int bj = 0; bj < 2; ++bj)
#pragma unroll
                    for (int n = 0; n < 2; ++n) { f32x4 v = acc[ai][bj][m][n];
                        { const f32x4 b = *(const f32x4*)(rp + bj * 128 + n * 16); v = v + b; *(f32x4*)(out + off + bj * 128 + n * 16) = v;
                            if (hb) { u32x2 w; w.x = pk2(v[0], v[1]); w.y = pk2(v[2], v[3]); *(u32x2*)(hb + off + bj * 128 + n * 16) = w; } }
                        ss += (v[0] * v[0] + v[1] * v[1]) + (v[2] * v[2] + v[3] * v[3]); }
                ss += __shfl_xor(ss, 16); ss += __shfl_xor(ss, 32);
                if (fq == 0) part[(size_t)row * 16 + u.pn * 4 + wc] = ss;
                if (m & 1) asm volatile("" ::: "memory"); }
    }
};

__device__ __forceinline__ void transpose_item(const float* W, int K, int N, bf16* WT, LAS float* scr, int item, int lane, const float* ks) {
    const int nblk = N / 32, kb = item / nblk, nb = item % nblk, k0 = 64 * kb, n0 = 32 * nb;
#pragma unroll 8
    for (int i = 0; i < 32; ++i) { const int kk = 2 * i + (lane >> 5); float v = W[(size_t)(k0 + kk) * N + n0 + (lane & 31)]; if (ks) v *= ks[k0 + kk]; scr[kk * 33 + (lane & 31)] = v; }
    LDS_WAIT();
    const int c = lane & 7;
#pragma unroll
    for (int j = 0; j < 4; ++j) { const int n = (lane >> 3) + 8 * j; const LAS float* s = scr + (8 * c) * 33 + n;
        u32x4 o; o.x = pk2(s[0 * 33], s[1 * 33]); o.y = pk2(s[2 * 33], s[3 * 33]); o.z = pk2(s[4 * 33], s[5 * 33]); o.w = pk2(s[6 * 33], s[7 * 33]);
        *(u32x4*)(WT + (size_t)(n0 + n) * K + k0 + 8 * c) = o; }
    LDS_WAIT();
}
__device__ __forceinline__ void rms_row_to_bf16(const float* xrow, const float* g, bf16* orow, int lane) {
    unsigned long long* o8 = (unsigned long long*)orow + lane;
    if (!xrow) {
#pragma unroll
        for (int j = 0; j < 4; ++j) o8[64 * j] = 0ull;
        return; }
    const f32x4* xr = (const f32x4*)xrow + lane; const f32x4* gr = (const f32x4*)g + lane;
    f32x4 v[4]; float s = 0.f;
#pragma unroll
    for (int j = 0; j < 4; ++j) { v[j] = xr[64 * j]; s += (v[j].x * v[j].x + v[j].y * v[j].y) + (v[j].z * v[j].z + v[j].w * v[j].w); }
    const float rstd = 1.f / sqrtf(wave_sum(s) * (1.f / DM) + EPS);
#pragma unroll
    for (int j = 0; j < 4; ++j) { const f32x4 gg = gr[64 * j]; const f32x4 y = v[j] * rstd * gg;
        o8[64 * j] = (unsigned long long)pk2(y.x, y.y) | ((unsigned long long)pk2(y.z, y.w) << 32); }
}
__device__ __forceinline__ void rope_entry(int pos, int i, float& c, float& s) {
    const double ang = (double)pos * INVF[i];
    const double q = __builtin_rint(ang * 6.36619772367581382e-01);
    double r = __builtin_fma(-q, 1.57079632679489656e+00, ang); r = __builtin_fma(-q, 6.12323399573676604e-17, r);
    const double r2 = r * r;
    double sp = 1.0 / 6227020800.0; sp = sp * r2 - 1.0 / 39916800.0; sp = sp * r2 + 1.0 / 362880.0; sp = sp * r2 - 1.0 / 5040.0; sp = sp * r2 + 1.0 / 120.0; sp = sp * r2 - 1.0 / 6.0; sp = sp * r2 + 1.0; sp = sp * r;
    double cp = 1.0 / 479001600.0; cp = cp * r2 - 1.0 / 3628800.0; cp = cp * r2 + 1.0 / 40320.0; cp = cp * r2 - 1.0 / 720.0; cp = cp * r2 + 1.0 / 24.0; cp = cp * r2 - 0.5; cp = cp * r2 + 1.0;
    const int qi = (int)((long long)q & 3);
    const double sv = (qi == 0) ? sp : (qi == 1) ? cp : (qi == 2) ? -sp : -cp;
    const double cv = (qi == 0) ? cp : (qi == 1) ? -sp : (qi == 2) ? -cp : sp;
    c = (float)cv; s = (float)sv;
}

constexpr int LP = 136;
constexpr int T_BYTES = 128 * LP * 2;
__device__ __forceinline__ void stage_vt(LAS bf16* VT, const bf16* Z, int rowbase, int L, int h, int tid) {
    const int j = tid >> 2, q4 = tid & 3; const bool valid = j < L;
    const bf16* vp = Z + (size_t)(rowbase + j) * INW + ZC_V + h * HD + q4 * 32;
#pragma unroll
    for (int c = 0; c < 4; ++c) { u32x4 w = valid ? *(const u32x4*)(vp + c * 8) : (u32x4){0u, 0u, 0u, 0u};
#pragma unroll
        for (int k = 0; k < 4; ++k) { const int e = q4 * 32 + c * 8 + 2 * k; VT[e * LP + j] = (bf16)(w[k] & 0xffffu); VT[(e + 1) * LP + j] = (bf16)(w[k] >> 16); } }
}
__device__ __forceinline__ void load_krot(const bf16* Z, const float* COS, const float* SIN, int rowbase, int posbase, int j, int q4, int h, float sc, float (&lo)[16], float (&hi)[16]) {
    const bf16* kp = Z + (size_t)(rowbase + j) * INW + ZC_K + h * HD + q4 * 16;
    const float* cp = COS + (size_t)(posbase + j) * 64 + q4 * 16; const float* sp = SIN + (size_t)(posbase + j) * 64 + q4 * 16;
#pragma unroll
    for (int c = 0; c < 2; ++c) { const u32x4 a = *(const u32x4*)(kp + c * 8), b = *(const u32x4*)(kp + 64 + c * 8);
#pragma unroll
        for (int k = 0; k < 4; ++k) { const f32x4 cc = *(const f32x4*)(cp + c * 8 + (k >> 1) * 4), ss = *(const f32x4*)(sp + c * 8 + (k >> 1) * 4);
            const float x1a = bflo(a[k]), x1b = bfhi(a[k]), x2a = bflo(b[k]), x2b = bfhi(b[k]);
            const float c0 = cc[(k & 1) * 2], c1 = cc[(k & 1) * 2 + 1], s0 = ss[(k & 1) * 2], s1 = ss[(k & 1) * 2 + 1];
            lo[c * 8 + 2 * k] = (x1a * c0 - x2a * s0) * sc; lo[c * 8 + 2 * k + 1] = (x1b * c1 - x2b * s1) * sc;
            hi[c * 8 + 2 * k] = (x1a * s0 + x2a * c0) * sc; hi[c * 8 + 2 * k + 1] = (x1b * s1 + x2b * c1) * sc; } }
}

__device__ __forceinline__ void kv_unit(LAS unsigned char* lds, const bf16* Z, const float* COS, const float* SIN, int rowbase, int posbase, int L, int h, float* outp, int tid, int wave, int lane) {
    LAS bf16* KT = (LAS bf16*)lds; LAS bf16* VT = (LAS bf16*)(lds + T_BYTES);
    const float lg = log_gamma(h);
    { const int j = tid >> 2, q4 = tid & 3;
      if (j < L) { float lo[16], hi[16]; const float sc = 0.08838834764831845f * __expf((float)(L - 1 - j) * lg);
          load_krot(Z, COS, SIN, rowbase, posbase, j, q4, h, sc, lo, hi);
#pragma unroll
          for (int d = 0; d < 16; ++d) { KT[(q4 * 16 + d) * LP + j] = (bf16)f2bf(lo[d]); KT[(64 + q4 * 16 + d) * LP + j] = (bf16)f2bf(hi[d]); }
      } else {
#pragma unroll
          for (int d = 0; d < 16; ++d) { KT[(q4 * 16 + d) * LP + j] = 0; KT[(64 + q4 * 16 + d) * LP + j] = 0; } }
      stage_vt(VT, Z, rowbase, L, h, tid); }
    __syncthreads();
    const int fr = lane & 15, fq = lane >> 4;
    f32x4 acc[8];
#pragma unroll
    for (int n = 0; n < 8; ++n) acc[n] = (f32x4){0.f, 0.f, 0.f, 0.f};
#pragma unroll
    for (int ks = 0; ks < 4; ++ks) { const bf16x8 a = *(const LAS bf16x8*)(KT + (16 * wave + fr) * LP + ks * 32 + fq * 8);
#pragma unroll
        for (int n = 0; n < 8; ++n) { const bf16x8 b = *(const LAS bf16x8*)(VT + (16 * n + fr) * LP + ks * 32 + fq * 8);
            acc[n] = __builtin_amdgcn_mfma_f32_16x16x32_bf16(a, b, acc[n], 0, 0, 0); } }
#pragma unroll
    for (int n = 0; n < 8; ++n) *(f32x4*)(outp + (size_t)(16 * n + fr) * HD + 16 * wave + 4 * fq) = acc[n];
    __syncthreads();
}

__device__ __forceinline__ void ret_unit(LAS unsigned char* lds, const bf16* Z, const float* COS, const float* SIN, const bf16* STg, bf16* YMIX, int rowbase, int posbase, int h, int tid, int wave, int lane) {
    LAS bf16* KR = (LAS bf16*)lds; LAS bf16* VT = (LAS bf16*)(lds + T_BYTES); LAS bf16* STL = (LAS bf16*)(lds + 2 * T_BYTES);
    LAS bf16* PW = (LAS bf16*)(lds + 3 * T_BYTES) + wave * 16 * LP;
    const float lg = log_gamma(h);
    { const int j = tid >> 2, q4 = tid & 3; float lo[16], hi[16];
      load_krot(Z, COS, SIN, rowbase, posbase, j, q4, h, 0.08838834764831845f, lo, hi);
#pragma unroll
      for (int c = 0; c < 2; ++c) { u32x4 wl, wh;
#pragma unroll
          for (int k = 0; k < 4; ++k) { wl[k] = pk2(lo[c * 8 + 2 * k], lo[c * 8 + 2 * k + 1]); wh[k] = pk2(hi[c * 8 + 2 * k], hi[c * 8 + 2 * k + 1]); }
          *(LAS u32x4*)(KR + j * LP + q4 * 16 + c * 8) = wl; *(LAS u32x4*)(KR + j * LP + 64 + q4 * 16 + c * 8) = wh; }
      stage_vt(VT, Z, rowbase, 128, h, tid);
#pragma unroll
      for (int i = 0; i < 4; ++i) { const int idx = tid + 512 * i, e = idx >> 4, dc = idx & 15; *(LAS u32x4*)(STL + e * LP + dc * 8) = *(const u32x4*)(STg + (size_t)e * HD + dc * 8); } }
    const int fr = lane & 15, fq = lane >> 4;
    bf16x8 Qa[4], Qd[4];
    { const int i = 16 * wave + fr; const bf16* qp = Z + (size_t)(rowbase + i) * INW + ZC_Q + h * HD + fq * 8;
      const float* cp = COS + (size_t)(posbase + i) * 64 + fq * 8; const float* sp = SIN + (size_t)(posbase + i) * 64 + fq * 8;
      const float qdec = __expf((float)(i + 1) * lg);
#pragma unroll
      for (int kk = 0; kk < 2; ++kk) { const u32x4 a = *(const u32x4*)(qp + kk * 32), b = *(const u32x4*)(qp + 64 + kk * 32);
          const f32x4 c0 = *(const f32x4*)(cp + kk * 32), c1 = *(const f32x4*)(cp + kk * 32 + 4), s0 = *(const f32x4*)(sp + kk * 32), s1 = *(const f32x4*)(sp + kk * 32 + 4);
          u32x4 r1, r2, d1, d2;
#pragma unroll
          for (int k = 0; k < 4; ++k) { const float x1a = bflo(a[k]), x1b = bfhi(a[k]), x2a = bflo(b[k]), x2b = bfhi(b[k]);
              const float ca = (k < 2) ? c0[2 * k] : c1[2 * k - 4], cb = (k < 2) ? c0[2 * k + 1] : c1[2 * k - 3], sa = (k < 2) ? s0[2 * k] : s1[2 * k - 4], sb = (k < 2) ? s0[2 * k + 1] : s1[2 * k - 3];
              const float ya = x1a * ca - x2a * sa, yb = x1b * cb - x2b * sb, za = x1a * sa + x2a * ca, zb = x1b * sb + x2b * cb;
              r1[k] = pk2(ya, yb); r2[k] = pk2(za, zb); d1[k] = pk2(ya * qdec, yb * qdec); d2[k] = pk2(za * qdec, zb * qdec); }
          Qa[kk] = __builtin_bit_cast(bf16x8, r1); Qa[kk + 2] = __builtin_bit_cast(bf16x8, r2); Qd[kk] = __builtin_bit_cast(bf16x8, d1); Qd[kk + 2] = __builtin_bit_cast(bf16x8, d2); } }
    __syncthreads();
    const float lg2 = lg * 1.4426950408889634f;
    for (int jt = 0; jt <= wave; ++jt) { f32x4 s = (f32x4){0.f, 0.f, 0.f, 0.f};
#pragma unroll
        for (int ks = 0; ks < 4; ++ks) { const bf16x8 kf = *(const LAS bf16x8*)(KR + (16 * jt + fr) * LP + ks * 32 + fq * 8); s = __builtin_amdgcn_mfma_f32_16x16x32_bf16(Qa[ks], kf, s, 0, 0, 0); }
#pragma unroll
        for (int r = 0; r < 4; ++r) { const int dif = (16 * wave + 4 * fq + r) - (16 * jt + fr); const float v = dif >= 0 ? s[r] * __builtin_amdgcn_exp2f((float)dif * lg2) : 0.f;
            PW[(4 * fq + r) * LP + 16 * jt + fr] = (bf16)f2bf(v); } }
    if (!(wave & 1)) {
#pragma unroll
        for (int r = 0; r < 4; ++r) PW[(4 * fq + r) * LP + 16 * (wave + 1) + fr] = 0; }
    LDS_WAIT();
    f32x4 acc[8];
#pragma unroll
    for (int n = 0; n < 8; ++n) acc[n] = (f32x4){0.f, 0.f, 0.f, 0.f};
    const int nks = (wave >> 1) + 1;
    for (int ks = 0; ks < nks; ++ks) { const bf16x8 pf = *(const LAS bf16x8*)(PW + fr * LP + ks * 32 + fq * 8);
#pragma unroll
        for (int n = 0; n < 8; ++n) { const bf16x8 vf = *(const LAS bf16x8*)(VT + (16 * n + fr) * LP + ks * 32 + fq * 8); acc[n] = __builtin_amdgcn_mfma_f32_16x16x32_bf16(pf, vf, acc[n], 0, 0, 0); } }
#pragma unroll
    for (int ks = 0; ks < 4; ++ks) {
#pragma unroll
        for (int n = 0; n < 8; ++n) { const bf16x8 sf = *(const LAS bf16x8*)(STL + (16 * n + fr) * LP + ks * 32 + fq * 8); acc[n] = __builtin_amdgcn_mfma_f32_16x16x32_bf16(Qd[ks], sf, acc[n], 0, 0, 0); } }
#pragma unroll
    for (int r = 0; r < 4; ++r) { float ss = 0.f;
#pragma unroll
        for (int n = 0; n < 8; ++n) ss += acc[n][r] * acc[n][r];
        ss += __shfl_xor(ss, 1); ss += __shfl_xor(ss, 2); ss += __shfl_xor(ss, 4); ss += __shfl_xor(ss, 8);
        const float rstd = 1.f / sqrtf(ss * (1.f / HD) + EPS);
        const size_t row = (size_t)(rowbase + 16 * wave + 4 * fq + r);
        const bf16* gp = Z + row * INW + ZC_G + h * HD + fr; bf16* yp = YMIX + row * DM + 512 + h * HD + fr;
#pragma unroll
        for (int n = 0; n < 8; ++n) { const float g = bf2f(gp[16 * n]); const float y = acc[n][r] * rstd * (g / (1.f + __expf(-g))); yp[16 * n] = (bf16)f2bf(y); } }
    __syncthreads();
}


template <int K> __device__ __forceinline__ void mini_mma(const bf16* A, const bf16* Bt, int n0, int wave, int fr, int fq, f32x4 (&acc)[2]) {
    const bf16* ap = A + (size_t)(16 * wave + fr) * K + fq * 8; const bf16* b0 = Bt + (size_t)(n0 + fr) * K + fq * 8; const bf16* b1 = b0 + (size_t)16 * K;
    acc[0] = (f32x4){0.f, 0.f, 0.f, 0.f}; acc[1] = (f32x4){0.f, 0.f, 0.f, 0.f};
#pragma unroll 8
    for (int ks = 0; ks < K / 32; ++ks) { const bf16x8 av = *(const bf16x8*)(ap + ks * 32), x0 = *(const bf16x8*)(b0 + ks * 32), x1 = *(const bf16x8*)(b1 + ks * 32);
        acc[0] = __builtin_amdgcn_mfma_f32_16x16x32_bf16(av, x0, acc[0], 0, 0, 0); acc[1] = __builtin_amdgcn_mfma_f32_16x16x32_bf16(av, x1, acc[1], 0, 0, 0); }
}

struct Args { const float* in[13]; float* out; unsigned char* ws; };
__global__ void __launch_bounds__(512, 2) hymba_fwd(Args a) {
    extern __shared__ __attribute__((aligned(16))) unsigned char lds_raw[];
    LAS unsigned char* lds = (LAS unsigned char*)lds_raw;
    cg::grid_group grid = cg::this_grid();
    const int tid = threadIdx.x, lane = tid & 63, wave = __builtin_amdgcn_readfirstlane(tid >> 6);
    const int G = gridDim.x, bid = blockIdx.x;
    const float* x_prompt = a.in[0]; const float* x_sample = a.in[1]; const float* cache_conv = a.in[2]; const float* state_ret = a.in[3]; const float* meta = a.in[4];
    const float* norm_mix = a.in[5]; const float* w_in = a.in[6]; const float* conv_w = a.in[7]; const float* w_out = a.in[8]; const float* norm_mlp = a.in[9];
    const float* w_up = a.in[10]; const float* w_down = a.in[11]; const float* norm_final = a.in[12];
    float* out = a.out; unsigned char* ws = a.ws;
    float* PART1 = (float*)(ws + WS_PART1); float* PART2 = (float*)(ws + WS_PART2);
    bf16* W1t = (bf16*)(ws + WS_W1); bf16* W2t = (bf16*)(ws + WS_W2); bf16* W3t = (bf16*)(ws + WS_W3); bf16* W4t = (bf16*)(ws + WS_W4);
    bf16* XN = (bf16*)(ws + WS_XN); bf16* STb = (bf16*)(ws + WS_ST); bf16* H1B = (bf16*)(ws + WS_H1B);
    bf16* Z = (bf16*)(ws + WS_Z); bf16* YMIX = (bf16*)(ws + WS_YMIX); bf16* HID = (bf16*)(ws + WS_HID);
    float* KV = (float*)(ws + WS_KV); float* KVM = (float*)(ws + WS_KVM); float* COS = (float*)(ws + WS_COS); float* SIN = (float*)(ws + WS_SIN);
    bf16* HIDS = (bf16*)(ws + WS_HIDS); float* PARTS1 = (float*)(ws + WS_PARTS1); float* PARTS2 = (float*)(ws + WS_PARTS2);
    const int gw = bid * 8 + wave, NGW = G * 8;

    {
        LAS float* scr = (LAS float*)(lds + wave * 16384);
        constexpr int I1 = (DM / 64) * (INW / 32), I2 = (DM / 64) * (DM / 32), I3 = (DM / 64) * (FF / 32), I4 = (FF / 64) * (DM / 32);
        for (int it = gw; it < I1 + I2 + I3 + I4; it += NGW) {
            int r = it;
            if (r < I1) { transpose_item(w_in, DM, INW, W1t, scr, r, lane, nullptr); continue; } r -= I1;
            if (r < I2) { transpose_item(w_out, DM, DM, W2t, scr, r, lane, nullptr); continue; } r -= I2;
            if (r < I3) { transpose_item(w_up, DM, FF, W3t, scr, r, lane, norm_mlp); continue; } r -= I3;
            transpose_item(w_down, FF, DM, W4t, scr, r, lane, nullptr);
        }
        for (int m = gw; m < MPAD; m += NGW) {
            const float* xr = m < MP ? x_prompt + (size_t)m * DM : m < ROW_M ? x_sample + (size_t)(m - ROW_S) * DM : m < ROW_M + 16 ? meta + (size_t)(m - ROW_M) * DM : nullptr;
            rms_row_to_bf16(xr, norm_mix, XN + (size_t)m * DM, lane);
        }
        for (int idx = bid * 512 + tid; idx < NPOS * 64; idx += G * 512) { const int p = idx >> 6, i = idx & 63; float c, s; rope_entry(p < 2064 ? p : 16384, i, c, s); COS[idx] = c; SIN[idx] = s; }
    }
    grid.sync();

    { pg8::Gemm g{XN, W1t, MPAD, INW, DM}; pg8::StaticOrder S; S.init(MPAD, INW, G, bid); EpiZ E{Z, INW};
      pg8::gemm_phase<EpiZ, pg8::StaticOrder, true, PG8_SP2>(lds, g, S, E); }
    grid.sync();

    for (int u = bid; u < 4 + NB * NH * NCH; u += G) {
        if (u < 4) kv_unit(lds, Z, COS, SIN, ROW_M, 0, 16, u, KVM + (size_t)u * HD * HD, tid, wave, lane);
        else { const int uu = u - 4, c = uu & 15, h = (uu >> 4) & 3, b = uu >> 6;
            kv_unit(lds, Z, COS, SIN, b * SEQ + c * 128, 16 + c * 128, 128, h, KV + (size_t)uu * HD * HD, tid, wave, lane); }
    }
    for (int it = bid; it < MP / 64; it += G) {
        const int tg = tid >> 6, c8 = (tid & 63) * 8, t0 = it * 64 + tg * 8, tin = t0 & (SEQ - 1), b = t0 >> 11;
        const int rm2 = tin == 0 ? ROW_M + 14 : t0 - 2, rm1 = tin == 0 ? ROW_M + 15 : t0 - 1;
        float w0[8], w1[8], w2[8], p2[8], p1[8];
#pragma unroll
        for (int k = 0; k < 8; ++k) { w0[k] = conv_w[c8 + k]; w1[k] = conv_w[512 + c8 + k]; w2[k] = conv_w[1024 + c8 + k]; }
        { const u32x4 ua = *(const u32x4*)(Z + (size_t)rm2 * INW + ZC_U + c8), ca = *(const u32x4*)(Z + (size_t)rm2 * INW + ZC_C + c8);
          const u32x4 ub = *(const u32x4*)(Z + (size_t)rm1 * INW + ZC_U + c8), cb = *(const u32x4*)(Z + (size_t)rm1 * INW + ZC_C + c8);
#pragma unroll
          for (int k = 0; k < 4; ++k) { p2[2 * k] = bflo(ua[k]) * bflo(ca[k]); p2[2 * k + 1] = bfhi(ua[k]) * bfhi(ca[k]); p1[2 * k] = bflo(ub[k]) * bflo(cb[k]); p1[2 * k + 1] = bfhi(ub[k]) * bfhi(cb[k]); } }
        for (int k8 = 0; k8 < 8; ++k8) { const size_t row = (size_t)(t0 + k8);
            const u32x4 uu = *(const u32x4*)(Z + row * INW + ZC_U + c8), cc = *(const u32x4*)(Z + row * INW + ZC_C + c8), bb = *(const u32x4*)(Z + row * INW + ZC_B + c8);
            float cu[8], y[8];
#pragma unroll
            for (int k = 0; k < 4; ++k) { cu[2 * k] = bflo(uu[k]) * bflo(cc[k]); cu[2 * k + 1] = bfhi(uu[k]) * bfhi(cc[k]); }
#pragma unroll
            for (int k = 0; k < 4; ++k) { y[2 * k] = bflo(bb[k]) * (w0[2 * k] * p2[2 * k] + w1[2 * k] * p1[2 * k] + w2[2 * k] * cu[2 * k]);
                y[2 * k + 1] = bfhi(bb[k]) * (w0[2 * k + 1] * p2[2 * k + 1] + w1[2 * k + 1] * p1[2 * k + 1] + w2[2 * k + 1] * cu[2 * k + 1]); }
            u32x4 yo; yo.x = pk2(y[0], y[1]); yo.y = pk2(y[2], y[3]); yo.z = pk2(y[4], y[5]); yo.w = pk2(y[6], y[7]);
            *(u32x4*)(YMIX + row * DM + c8) = yo;
            if (tin + k8 >= SEQ - 2) { float* cp = out + O_CP + ((size_t)b * 2 + (tin + k8 - (SEQ - 2))) * 512 + c8;
                *(f32x4*)cp = (f32x4){cu[0], cu[1], cu[2], cu[3]}; *(f32x4*)(cp + 4) = (f32x4){cu[4], cu[5], cu[6], cu[7]}; }
#pragma unroll
            for (int k = 0; k < 8; ++k) { p2[k] = p1[k]; p1[k] = cu[k]; } }
    }
    for (int it = bid; it < NSAMP / 8; it += G) {
        const int b = it * 8 + (tid >> 6), c8 = (tid & 63) * 8; const size_t row = (size_t)(ROW_S + b);
        const u32x4 uu = *(const u32x4*)(Z + row * INW + ZC_U + c8), cc = *(const u32x4*)(Z + row * INW + ZC_C + c8), bb = *(const u32x4*)(Z + row * INW + ZC_B + c8);
        const float* pc = cache_conv + (size_t)b * 1024 + c8; float* nc = out + O_CS + (size_t)b * 1024 + c8;
        float cu[8], y[8], p2[8], p1[8];
#pragma unroll
        for (int k = 0; k < 8; ++k) { p2[k] = pc[k]; p1[k] = pc[512 + k]; }
#pragma unroll
        for (int k = 0; k < 4; ++k) { cu[2 * k] = bflo(uu[k]) * bflo(cc[k]); cu[2 * k + 1] = bfhi(uu[k]) * bfhi(cc[k]); }
#pragma unroll
        for (int k = 0; k < 8; ++k) { const float bg = (k & 1) ? bfhi(bb[k >> 1]) : bflo(bb[k >> 1]);
            y[k] = bg * (conv_w[c8 + k] * p2[k] + conv_w[512 + c8 + k] * p1[k] + conv_w[1024 + c8 + k] * cu[k]); nc[k] = p1[k]; nc[512 + k] = cu[k]; }
        u32x4 yo; yo.x = pk2(y[0], y[1]); yo.y = pk2(y[2], y[3]); yo.z = pk2(y[4], y[5]); yo.w = pk2(y[6], y[7]);
        *(u32x4*)(YMIX + row * DM + c8) = yo;
    }
    for (int it = bid; it < NSAMP * NH; it += G) {
        const int b = it >> 2, h = it & 3; const size_t row = (size_t)(ROW_S + b);
        LAS float* sq = (LAS float*)lds; LAS float* sk = sq + 128; LAS float* sv = sq + 256; LAS float* red = sq + 384; LAS float* tot = sq + 384 + 16 * 128;
        if (tid < 128) { const int d = tid, dd = d & 63; const float c = COS[2064 * 64 + dd], s = SIN[2064 * 64 + dd];
            const bf16* zr = Z + row * INW + h * HD;
            const float q1 = bf2f(zr[ZC_Q + dd]), q2 = bf2f(zr[ZC_Q + dd + 64]), k1 = bf2f(zr[ZC_K + dd]), k2 = bf2f(zr[ZC_K + dd + 64]);
            sq[d] = d < 64 ? q1 * c - q2 * s : q1 * s + q2 * c; sk[d] = (d < 64 ? k1 * c - k2 * s : k1 * s + k2 * c) * 0.08838834764831845f; sv[d] = bf2f(zr[ZC_V + d]); }
        __syncthreads();
        const float gam = 1.0f - 1.0f / (float)(32 << h);
        const int e4 = tid & 31, dg = tid >> 5;
        const float* sp = state_ret + ((size_t)(b * NH + h) * HD) * HD + e4 * 4; float* np = out + O_RS + ((size_t)(b * NH + h) * HD) * HD + e4 * 4;
        const f32x4 vv = *(const LAS f32x4*)(sv + e4 * 4); f32x4 o = (f32x4){0.f, 0.f, 0.f, 0.f};
#pragma unroll
        for (int i2 = 0; i2 < 8; ++i2) { const int d = dg * 8 + i2; const f32x4 S0 = *(const f32x4*)(sp + (size_t)d * HD); const f32x4 Sn = S0 * gam + vv * sk[d];
            *(f32x4*)(np + (size_t)d * HD) = Sn; o = o + Sn * sq[d]; }
        *(LAS f32x4*)(red + dg * 128 + e4 * 4) = o;
        __syncthreads();
        float oe = 0.f;
        if (tid < 128) {
#pragma unroll
            for (int g2 = 0; g2 < 16; ++g2) oe += red[g2 * 128 + tid];
            const float ss = wave_sum(oe * oe); if (lane == 0) tot[wave] = ss; }
        __syncthreads();
        if (tid < 128) { const float rstd = 1.f / sqrtf((tot[0] + tot[1]) * (1.f / HD) + EPS); const float g = bf2f(Z[row * INW + ZC_G + h * HD + tid]);
            YMIX[row * DM + 512 + h * HD + tid] = (bf16)f2bf(oe * rstd * (g / (1.f + __expf(-g)))); }
        __syncthreads();
    }
    grid.sync();

    for (int it = bid; it < 256; it += G) {
        const int gid = it * 512 + tid, bh = gid >> 12, idx4 = gid & 4095, h = bh & 3; const size_t off = (size_t)idx4 * 4;
        const float gam = 1.0f - 1.0f / (float)(32 << h); float g128 = gam;
#pragma unroll
        for (int k = 0; k < 7; ++k) g128 *= g128;
        f32x4 s = *(const f32x4*)(KVM + (size_t)h * HD * HD + off);
        for (int c = 0; c < NCH; ++c) { const size_t ub = ((size_t)bh * NCH + c) * HD * HD + off;
            u32x2 w; w.x = pk2(s[0], s[1]); w.y = pk2(s[2], s[3]); *(u32x2*)(STb + ub) = w;
            const f32x4 kv = *(const f32x4*)(KV + ub); s = s * g128 + kv; }
        LAS float* T = (LAS float*)lds; const int el = tid >> 5, d0 = (tid & 31) * 4, e0 = (it & 7) * 16;
#pragma unroll
        for (int r = 0; r < 4; ++r) T[(d0 + r) * 17 + el] = s[r];
        __syncthreads();
        { const int d = tid >> 2, q = tid & 3; f32x4 o; o.x = T[d * 17 + q * 4]; o.y = T[d * 17 + q * 4 + 1]; o.z = T[d * 17 + q * 4 + 2]; o.w = T[d * 17 + q * 4 + 3];
          *(f32x4*)(out + O_RP + ((size_t)bh * HD + d) * HD + e0 + q * 4) = o; }
        __syncthreads();
    }
    if (bid < 32) {
        const int fr = lane & 15, fq = lane >> 4, n0 = bid * 32; f32x4 acc[2];
        mini_mma<DM>(YMIX + (size_t)ROW_S * DM, W2t, n0, wave, fr, fq, acc);
#pragma unroll
        for (int r = 0; r < 4; ++r) { const int row = 16 * wave + 4 * fq + r; float ss = 0.f;
#pragma unroll
            for (int t = 0; t < 2; ++t) { const size_t o = (size_t)row * DM + n0 + 16 * t + fr; const float v = acc[t][r] + x_sample[o]; out[O_YS + o] = v; H1B[(size_t)ROW_S * DM + o] = (bf16)f2bf(v); ss += v * v; }
            ss += __shfl_xor(ss, 1); ss += __shfl_xor(ss, 2); ss += __shfl_xor(ss, 4); ss += __shfl_xor(ss, 8);
            if (fr == 0) PARTS1[row * 32 + bid] = ss; }
    }
    grid.sync();

    for (int u = bid; u < NB * NH * NCH; u += G) { const int c = u & 15, h = (u >> 4) & 3, b = u >> 6;
        ret_unit(lds, Z, COS, SIN, STb + (size_t)u * HD * HD, YMIX, b * SEQ + c * 128, 16 + c * 128, h, tid, wave, lane); }
    if (bid < 128) {
        const int fr = lane & 15, fq = lane >> 4, n0 = bid * 32; f32x4 acc[2];
        float rstdv; { const f32x4* p = (const f32x4*)(PARTS1 + (16 * wave + (lane >> 2)) * 32 + (lane & 3) * 8); const f32x4 a0 = p[0], a1 = p[1];
            float ss = ((a0[0] + a0[1]) + (a0[2] + a0[3])) + ((a1[0] + a1[1]) + (a1[2] + a1[3])); ss += __shfl_xor(ss, 1); ss += __shfl_xor(ss, 2); rstdv = 1.f / sqrtf(ss * (1.f / DM) + EPS); }
        mini_mma<DM>(H1B + (size_t)ROW_S * DM, W3t, n0, wave, fr, fq, acc);
#pragma unroll
        for (int r = 0; r < 4; ++r) { const int row = 16 * wave + 4 * fq + r; const float rs = __shfl(rstdv, (4 * fq + r) * 4);
#pragma unroll
            for (int t = 0; t < 2; ++t) { const float v = fmaxf(acc[t][r] * rs, 0.f); HIDS[(size_t)row * FF + n0 + 16 * t + fr] = (bf16)f2bf(v * v); } }
    }
    grid.sync();

    if (bid < 32) {
        const int fr = lane & 15, fq = lane >> 4, n0 = bid * 32; f32x4 acc[2];
        mini_mma<FF>(HIDS, W4t, n0, wave, fr, fq, acc);
#pragma unroll
        for (int r = 0; r < 4; ++r) { const int row = 16 * wave + 4 * fq + r; float ss = 0.f;
#pragma unroll
            for (int t = 0; t < 2; ++t) { const size_t o = O_YS + (size_t)row * DM + n0 + 16 * t + fr; const float v = acc[t][r] + out[o]; out[o] = v; ss += v * v; }
            ss += __shfl_xor(ss, 1); ss += __shfl_xor(ss, 2); ss += __shfl_xor(ss, 4); ss += __shfl_xor(ss, 8);
            if (fr == 0) PARTS2[row * 32 + bid] = ss; }
    }
    { pg8::Gemm g{YMIX, W2t, MP, DM, DM}; pg8::StaticOrder S; S.init(MP, DM, G, bid); EpiRes E{x_prompt, x_sample, out, H1B, PART1};
      pg8::gemm_phase<EpiRes, pg8::StaticOrder, true, PG8_SP2>(lds, g, S, E); }
    grid.sync();

    { pg8::Gemm g{H1B, W3t, MP, FF, DM}; pg8::StaticOrder S; S.init(MP, FF, G, bid);
      LAS float* rs = (LAS float*)(lds + RING_BYTES);
      for (int idx = tid; idx < 4 * 256; idx += 512) { pg8::Unit u; if (S.next(idx >> 8, u)) { const f32x4* p = (const f32x4*)(PART1 + (size_t)(u.pm * 256 + (idx & 255)) * 16);
              const f32x4 a0 = p[0], a1 = p[1], a2 = p[2], a3 = p[3]; const float ss = ((a0[0] + a0[1]) + (a0[2] + a0[3])) + ((a1[0] + a1[1]) + (a1[2] + a1[3])) + ((a2[0] + a2[1]) + (a2[2] + a2[3])) + ((a3[0] + a3[1]) + (a3[2] + a3[3]));
              rs[idx] = 1.f / sqrtf(ss * (1.f / DM) + EPS); } }
      __syncthreads();
      EpiUp E{HID, FF, rs, 0};
      pg8::gemm_phase<EpiUp, pg8::StaticOrder, true, PG8_SP2>(lds, g, S, E); }
    grid.sync();

    { pg8::Gemm g{HID, W4t, MP, DM, FF}; pg8::StaticOrder S; S.init(MP, DM, G, bid); EpiRes E{out, out + (size_t)MP * DM, out, nullptr, PART2};
      pg8::gemm_phase<EpiRes, pg8::StaticOrder, true, PG8_SP2>(lds, g, S, E); }
    grid.sync();

    for (int m = gw; m < MV; m += NGW) {
        f32x4* xr = (f32x4*)(out + (size_t)m * DM) + lane; const f32x4* gr = (const f32x4*)norm_final + lane;
        const float pv = m < MP ? (lane < 16 ? PART2[(size_t)m * 16 + lane] : 0.f) : (lane < 32 ? PARTS2[(m - MP) * 32 + lane] : 0.f); const float rstd = 1.f / sqrtf(wave_sum(pv) * (1.f / DM) + EPS);
#pragma unroll
        for (int j = 0; j < 4; ++j) { const f32x4 v = xr[64 * j]; xr[64 * j] = v * rstd * gr[64 * j]; }
    }
}

extern "C" void kernel_launch(void* const* d_in, const int* in_sizes, int n_in, void* d_out, int out_size, void* d_ws, size_t ws_size, hipStream_t stream) {
    static int grid = 0;
    if (grid == 0) {
        if (n_in != 13 || ws_size < WS_END) { fprintf(stderr, "kernel_launch: unexpected n_in %d / ws_size %zu\n", n_in, ws_size); grid = -1; return; }
        int dev = 0, cus = 0, per_cu = 0;
        hipGetDevice(&dev); hipDeviceGetAttribute(&cus, hipDeviceAttributeMultiprocessorCount, dev);
        if (hipFuncSetAttribute((const void*)hymba_fwd, hipFuncAttributeMaxDynamicSharedMemorySize, LDS_BYTES) != hipSuccess) { fprintf(stderr, "kernel_launch: hipFuncSetAttribute failed\n"); grid = -1; return; }
        if (hipOccupancyMaxActiveBlocksPerMultiprocessor(&per_cu, (const void*)hymba_fwd, 512, LDS_BYTES) != hipSuccess || per_cu < 1) { fprintf(stderr, "kernel_launch: occupancy query says %d\n", per_cu); per_cu = 1; }
        (void)hipGetLastError();
        grid = cus * per_cu;
    }
    if (grid < 0) return;
    Args a{};
    for (int i = 0; i < 13; ++i) a.in[i] = (const float*)d_in[i];
    a.out = (float*)d_out; a.ws = (unsigned char*)d_ws;
    void* args[] = {&a};
    hipError_t e = hipLaunchCooperativeKernel((const void*)hymba_fwd, dim3(grid), dim3(512), args, LDS_BYTES, stream);
    if (e != hipSuccess) fprintf(stderr, "cooperative launch failed: %s (grid %d)\n", hipGetErrorString(e), grid);
}
```

```cpp
#include <hip/hip_runtime.h>
#include <hip/hip_cooperative_groups.h>
#include <cstdio>
#include <cstdint>
namespace cg = cooperative_groups;
namespace pg8 {
#define PG8_LAS __attribute__((address_space(3)))
typedef unsigned short bf16_t;
typedef short bf16x8 __attribute__((ext_vector_type(8)));
typedef float f32x4 __attribute__((ext_vector_type(4)));
typedef unsigned u32x4 __attribute__((ext_vector_type(4)));
constexpr int BM = 256, BK = 64, HALF = 128, HTB = HALF * BK * 2  , STAGE_BYTES = 8 * HTB, NXCD = 8, WGM = 8;

__host__ __device__ __forceinline__ int lds_byte(int r, int c) { const int st = (r >> 4) * 2 + (c >> 5), rr = r & 15, cc = c & 31, ob = rr * 64 + cc * 2; return st * 1024 + (ob ^ (((ob >> 9) & 1) << 5)); }
__host__ __device__ __forceinline__ void stage_rc(int b, int& R, int& C) { const int st = b / 1024, sb = b % 1024, swz = sb ^ (((sb >> 9) & 1) << 5); R = (st >> 1) * 16 + swz / 64; C = (st & 1) * 32 + (swz % 64) / 2; }
__host__ __device__ __forceinline__ int perm32(int rho) { const int n = rho >> 4, i = rho & 15; return 8 * (i >> 2) + 4 * n + (i & 3); }

struct Unit { int pm, pn; };
struct Gemm { const bf16_t* A; const bf16_t* Bt; int M, N, K; };

struct StaticOrder {
    int nM, nN, nwg, G, c;
    __host__ __device__ void init(int M, int N, int G_, int c_) { nM = M / BM; nN = N / BM; nwg = nM * nN; G = G_; c = c_; }
    __host__ __device__ bool next(int i, Unit& u) const {
        const long L = (long)i * G + c; if (L >= nwg) return false;
        int wgid = (int)L; { const int q = nwg / NXCD, r = nwg % NXCD, xcd = wgid % NXCD, off = wgid / NXCD; wgid = (xcd < r ? xcd * (q + 1) : r * (q + 1) + (xcd - r) * q) + off; }
        const int nig = WGM * nN, gid = wgid / nig, fm = gid * WGM, gsz = (nM - fm) < WGM ? (nM - fm) : WGM;
        u.pm = fm + ((wgid % nig) % gsz); u.pn = (wgid % nig) / gsz; return true;
    }
    __device__ __forceinline__ void a_ready(const Unit&) const {}
    __device__ __forceinline__ void done(const Unit&) const {}
};
__device__ __forceinline__ unsigned cvt_pk_bf16(float lo, float hi) { unsigned r; asm volatile("v_cvt_pk_bf16_f32 %0, %1, %2" : "=v"(r) : "v"(lo), "v"(hi)); return r; }
typedef float f32x2 __attribute__((ext_vector_type(2)));
template <class Epi, class Sched, bool ALIGN_EPI = false, bool SP2 = false>
__device__ __forceinline__ void gemm_phase(PG8_LAS unsigned char* lds, const Gemm g, const Sched& S, const Epi& E) {
    const int tid = threadIdx.x, wid = __builtin_amdgcn_readfirstlane(tid >> 6), lane = tid & 63, wr = wid >> 2, wc = wid & 3, fr = lane & 15, fq = lane >> 4;
    const int K = g.K, nt = K / BK;
    unsigned voffA[2], voffB[2];
#pragma unroll
    for (int i = 0; i < 2; ++i) { int R, C; stage_rc(tid * 16 + i * 8192, R, C); const int Rb = Epi::PERM ? ((R & ~31) + perm32(R & 31)) : R;
        voffA[i] = (unsigned)(R * K + C) * 2u; voffB[i] = (unsigned)(Rb * K + C) * 2u; }
    const size_t kstep = (size_t)(BK * 2);
    const size_t hstep = (size_t)HALF * K * 2;
    const size_t tstep = 2 * hstep;
    const unsigned ldsw = (unsigned)wid * 1024u;
    const int aoff = lds_byte(wr * 64 + fr, fq * 8), boff = lds_byte(wc * 32 + fr, fq * 8);
#define PG8_SA(b, h) (((b) * 2 + (h)) * HTB)
#define PG8_SB(b, h) ((4 + (b) * 2 + (h)) * HTB)
#define PG8_STAGE(bufoff, gbase, voff) do { _Pragma("unroll") for (int _i = 0; _i < 2; ++_i) \
        __builtin_amdgcn_global_load_lds((const unsigned*)((const char*)(gbase) + (voff)[_i]), (PG8_LAS unsigned*)(lds + (bufoff) + ldsw + _i * 8192), 16, 0, 0); } while (0)
#define PG8_LDA(dst, b, h) do { _Pragma("unroll") for (int m = 0; m < 4; ++m) _Pragma("unroll") for (int k = 0; k < 2; ++k) dst[m][k] = *(const PG8_LAS bf16x8*)(lds + PG8_SA(b, h) + aoff + m * 2048 + k * 1024); } while (0)
#define PG8_LDB(dst, b, h) do { _Pragma("unroll") for (int n = 0; n < 2; ++n) _Pragma("unroll") for (int k = 0; k < 2; ++k) dst[n][k] = *(const PG8_LAS bf16x8*)(lds + PG8_SB(b, h) + boff + n * 2048 + k * 1024); } while (0)
#define PG8_MMA(ai, bj, At, Bt) do { __builtin_amdgcn_s_setprio(1); _Pragma("unroll") for (int m = 0; m < 4; ++m) _Pragma("unroll") for (int n = 0; n < 2; ++n) _Pragma("unroll") for (int k = 0; k < 2; ++k) \
        acc[ai][bj][m][n] = __builtin_amdgcn_mfma_f32_16x16x32_bf16(Bt[n][k], At[m][k], acc[ai][bj][m][n], 0, 0, 0); __builtin_amdgcn_s_setprio(0); } while (0)
#define PG8_WAIT_V(n) asm volatile("s_waitcnt vmcnt(" #n ")" ::: "memory")
#define PG8_WAIT_L(n) asm volatile("s_waitcnt lgkmcnt(" #n ")" ::: "memory")
#define PG8_BAR __builtin_amdgcn_s_barrier()
#define PG8_SCHED __builtin_amdgcn_sched_barrier(0)
    Unit cur, nxt; int ui = 0;
    if (!S.next(0, cur)) return;
    f32x4 acc[2][2][4][2];
#pragma unroll
    for (int a = 0; a < 2; ++a)
#pragma unroll
        for (int b = 0; b < 2; ++b)
#pragma unroll
            for (int m = 0; m < 4; ++m)
#pragma unroll
                for (int n = 0; n < 2; ++n) acc[a][b][m][n] = (f32x4){0.f, 0.f, 0.f, 0.f};
    bf16x8 At[4][2], B0[2][2], B1[2][2];
    const char* cA = (const char*)g.A + (size_t)cur.pm * tstep; const char* cB = (const char*)g.Bt + (size_t)cur.pn * tstep;
    S.a_ready(cur);
    if constexpr (SP2) {
        PG8_STAGE(PG8_SB(0, 0), cB, voffB); PG8_STAGE(PG8_SB(0, 1), cB + hstep, voffB); PG8_STAGE(PG8_SA(0, 0), cA, voffA); PG8_STAGE(PG8_SA(0, 1), cA + hstep, voffA);
        if (wr == 1) PG8_BAR;
        PG8_WAIT_V(2); PG8_BAR;
        PG8_STAGE(PG8_SB(1, 0), cB + kstep, voffB); PG8_STAGE(PG8_SA(1, 0), cA + kstep, voffA); PG8_STAGE(PG8_SB(1, 1), cB + hstep + kstep, voffB);
        PG8_WAIT_V(6); PG8_BAR;
    } else {
        PG8_STAGE(PG8_SB(0, 0), cB, voffB); PG8_STAGE(PG8_SA(0, 0), cA, voffA); PG8_STAGE(PG8_SB(0, 1), cB + hstep, voffB); PG8_STAGE(PG8_SA(0, 1), cA + hstep, voffA);
        if (wr == 1) PG8_BAR;
        PG8_WAIT_V(4); PG8_BAR;
        PG8_STAGE(PG8_SB(1, 0), cB + kstep, voffB); PG8_STAGE(PG8_SA(1, 0), cA + kstep, voffA); PG8_STAGE(PG8_SB(1, 1), cB + hstep + kstep, voffB);
        PG8_WAIT_V(6); PG8_BAR;
    }
    for (;;) {
        const bool has_next = S.next(ui + 1, nxt);
        const char* nA = has_next ? (const char*)g.A + (size_t)nxt.pm * tstep : cA; const char* nB = has_next ? (const char*)g.Bt + (size_t)nxt.pn * tstep : cB;
        for (int t = 0; t < nt; t += 2) {
            const bool last = (t == nt - 2);
            const char* a1 = cA + (size_t)(t + 1) * kstep;
            const char* a2 = last ? nA : cA + (size_t)(t + 2) * kstep; const char* b2 = last ? nB : cB + (size_t)(t + 2) * kstep;
            const char* a3 = a2 + kstep; const char* b3 = b2 + kstep;
            if (last && has_next) S.a_ready(nxt);
            if constexpr (SP2) {
            PG8_LDB(B0, 0, 0); PG8_LDB(B1, 0, 1); PG8_SCHED; PG8_LDA(At, 0, 0); PG8_STAGE(PG8_SA(1, 1), a1 + hstep, voffA);
            PG8_WAIT_V(8); PG8_WAIT_L(0); PG8_BAR; PG8_MMA(0, 0, At, B0); PG8_MMA(0, 1, At, B1); PG8_BAR; PG8_SCHED;
            PG8_LDA(At, 0, 1); PG8_STAGE(PG8_SB(0, 0), b2, voffB); PG8_STAGE(PG8_SB(0, 1), b2 + hstep, voffB); PG8_STAGE(PG8_SA(0, 0), a2, voffA);
            PG8_WAIT_V(8); PG8_WAIT_L(0); PG8_BAR; PG8_MMA(1, 0, At, B0); PG8_MMA(1, 1, At, B1); PG8_BAR; PG8_SCHED;
            PG8_LDB(B0, 1, 0); PG8_LDB(B1, 1, 1); PG8_SCHED; PG8_LDA(At, 1, 0); PG8_STAGE(PG8_SA(0, 1), a2 + hstep, voffA);
            PG8_WAIT_V(8); PG8_WAIT_L(0); PG8_BAR; PG8_MMA(0, 0, At, B0); PG8_MMA(0, 1, At, B1); PG8_BAR; PG8_SCHED;
            PG8_LDA(At, 1, 1); PG8_STAGE(PG8_SB(1, 0), b3, voffB); PG8_STAGE(PG8_SB(1, 1), b3 + hstep, voffB); PG8_STAGE(PG8_SA(1, 0), a3, voffA);
            PG8_WAIT_V(8); PG8_WAIT_L(0); PG8_BAR; PG8_MMA(1, 0, At, B0); PG8_MMA(1, 1, At, B1); PG8_BAR; PG8_SCHED;
            } else {
            PG8_LDB(B0, 0, 0); PG8_SCHED; PG8_LDA(At, 0, 0); PG8_STAGE(PG8_SA(1, 1), a1 + hstep, voffA);
            PG8_WAIT_L(8); PG8_BAR; PG8_WAIT_L(0); PG8_MMA(0, 0, At, B0); PG8_BAR; PG8_SCHED;
            PG8_LDB(B1, 0, 1); PG8_STAGE(PG8_SB(0, 0), b2, voffB);
            PG8_BAR; PG8_WAIT_L(0); PG8_MMA(0, 1, At, B1); PG8_BAR;
            PG8_LDA(At, 0, 1); PG8_STAGE(PG8_SA(0, 0), a2, voffA);
            PG8_BAR; PG8_WAIT_L(0); PG8_MMA(1, 0, At, B0); PG8_BAR; PG8_SCHED;
            PG8_STAGE(PG8_SB(0, 1), b2 + hstep, voffB);
            PG8_WAIT_V(6); PG8_BAR; PG8_MMA(1, 1, At, B1); PG8_BAR;
            PG8_LDB(B0, 1, 0); PG8_SCHED; PG8_LDA(At, 1, 0); PG8_STAGE(PG8_SA(0, 1), a2 + hstep, voffA);
            PG8_WAIT_L(8); PG8_BAR; PG8_WAIT_L(0); PG8_MMA(0, 0, At, B0); PG8_BAR; PG8_SCHED;
            PG8_LDB(B1, 1, 1); PG8_STAGE(PG8_SB(1, 0), b3, voffB);
            PG8_BAR; PG8_WAIT_L(0); PG8_MMA(0, 1, At, B1); PG8_BAR;
            PG8_LDA(At, 1, 1); PG8_STAGE(PG8_SA(1, 0), a3, voffA);
            PG8_BAR; PG8_WAIT_L(0); PG8_MMA(1, 0, At, B0); PG8_BAR; PG8_SCHED;
            PG8_STAGE(PG8_SB(1, 1), b3 + hstep, voffB);
            PG8_WAIT_V(6); PG8_BAR; PG8_MMA(1, 1, At, B1); PG8_BAR;
            }
        }
        if constexpr (ALIGN_EPI) { if (wr == 0) PG8_BAR; }
        if constexpr (!Epi::AFTER_DRAIN) { E(acc, cur, wr, wc, fr, fq); S.done(cur); }
        if (!has_next) break;
#pragma unroll
        for (int a = 0; a < 2; ++a)
#pragma unroll
            for (int b = 0; b < 2; ++b)
#pragma unroll
                for (int m = 0; m < 4; ++m)
#pragma unroll
                    for (int n = 0; n < 2; ++n) acc[a][b][m][n] = (f32x4){0.f, 0.f, 0.f, 0.f};
        cur = nxt; cA = nA; cB = nB; ++ui;
        if constexpr (ALIGN_EPI) { if (wr == 1) PG8_BAR; }
    }
    PG8_WAIT_V(0);
    if constexpr (!ALIGN_EPI) { if (wr == 0) PG8_BAR; }
    PG8_BAR;
    if constexpr (Epi::AFTER_DRAIN) { E.fused(acc, cur, wr, wc, fr, fq, lds, wid, lane); S.done(cur); }
#undef PG8_SA
#undef PG8_SB
#undef PG8_STAGE
#undef PG8_LDA
#undef PG8_LDB
#undef PG8_MMA
#undef PG8_WAIT_V
#undef PG8_WAIT_L
#undef PG8_BAR
#undef PG8_SCHED
}
}
#ifndef REP_P0
#define REP_P0 1
#endif
#ifndef REP_KV
#define REP_KV 1
#endif
#ifndef REP_CONV
#define REP_CONV 1
#endif
#ifndef REP_SRET
#define REP_SRET 1
#endif
#ifndef REP_SCAN
#define REP_SCAN 1
#endif
#ifndef REP_S2
#define REP_S2 1
#endif
#ifndef REP_RET
#define REP_RET 1
#endif
#ifndef REP_S3
#define REP_S3 1
#endif
#ifndef REP_S4
#define REP_S4 1
#endif
#ifndef REP_SYNC
#define REP_SYNC 1
#endif

#ifndef PG8_SP2
#define PG8_SP2 true
#endif
#define LAS __attribute__((address_space(3)))
typedef unsigned short bf16;
typedef unsigned u32x4 __attribute__((ext_vector_type(4)));
typedef unsigned u32x2 __attribute__((ext_vector_type(2)));
typedef float f32x4 __attribute__((ext_vector_type(4)));
typedef short bf16x8 __attribute__((ext_vector_type(8)));

constexpr int DM = 1024, NB = 8, SEQ = 2048, NSAMP = 128, NH = 4, HD = 128, INW = 3584, FF = 4096, NCH = 16;
constexpr int MP = NB * SEQ;
constexpr int ROW_S = MP;
constexpr int ROW_M = MP + NSAMP;
constexpr int MV = MP + NSAMP;
constexpr int MPAD = 16640;
constexpr int ZC_U = 0, ZC_C = 512, ZC_B = 1024, ZC_Q = 1536, ZC_K = 2048, ZC_V = 2560, ZC_G = 3072;
constexpr float EPS = 1e-6f;
constexpr int NPOS = 2065;
constexpr size_t O_YP = 0, O_YS = 16777216, O_CP = 16908288, O_RP = 16916480, O_CS = 17440768, O_RS = 17571840;
constexpr size_t MiB = 1u << 20;
constexpr size_t WS_PART1 = 0, WS_PART2 = 3 * MiB / 2;
constexpr size_t WS_W1 = 3 * MiB, WS_W2 = 10 * MiB, WS_W3 = 12 * MiB, WS_W4 = 20 * MiB;
constexpr size_t WS_XN = 28 * MiB, WS_ST = WS_XN, WS_H1B = WS_XN;
constexpr size_t WS_Z = 61 * MiB, WS_YMIX = 175 * MiB, WS_HID = WS_Z;
constexpr size_t WS_KV = 208 * MiB, WS_KVM = 240 * MiB, WS_COS = 241 * MiB, WS_SIN = 242 * MiB, WS_HIDS = 243 * MiB, WS_PARTS1 = 244 * MiB, WS_PARTS2 = 244 * MiB + 65536, WS_CTL = 245 * MiB, WS_SPART = 246 * MiB, WS_END = 248 * MiB;
constexpr size_t CTL_BYTES = 16384;
constexpr int RING_BYTES = 131072, LDS_BYTES = 147456;

__device__ const double INVF[64] = {
1.00000000000000000e+00, 8.65964323360065347e-01, 7.49894209332455763e-01, 6.49381631576211316e-01,
5.62341325190349073e-01, 4.86967525165863058e-01, 4.21696503428582226e-01, 3.65174127254837666e-01,
3.16227766016837886e-01, 2.73841963426436075e-01, 2.37137370566165462e-01, 2.05352502645714585e-01,
1.77827941003892265e-01, 1.53992652605949160e-01, 1.33352143216332403e-01, 1.15478198468945775e-01,
9.99999999999999778e-02, 8.65964323360065291e-02, 7.49894209332455514e-02, 6.49381631576211177e-02,
5.62341325190348837e-02, 4.86967525165862974e-02, 4.21696503428582170e-02, 3.65174127254837555e-02,
3.16227766016837844e-02, 2.73841963426436075e-02, 2.37137370566165399e-02, 2.05352502645714530e-02,
1.77827941003892258e-02, 1.53992652605949125e-02, 1.33352143216332302e-02, 1.15478198468945796e-02,
9.99999999999999500e-03, 8.65964323360064736e-03, 7.49894209332455704e-03, 6.49381631576211038e-03,
5.62341325190348663e-03, 4.86967525165863096e-03, 4.21696503428582118e-03, 3.65174127254837451e-03,
3.16227766016837636e-03, 2.73841963426436040e-03, 2.37137370566165365e-03, 2.05352502645714426e-03,
1.77827941003892210e-03, 1.53992652605949095e-03, 1.33352143216332276e-03, 1.15478198468945770e-03,
9.99999999999999370e-04, 8.65964323360064519e-04, 7.49894209332455531e-04, 6.49381631576210908e-04,
5.62341325190348555e-04, 4.86967525165862933e-04, 4.21696503428581966e-04, 3.65174127254837375e-04,
3.16227766016837831e-04, 2.73841963426435726e-04, 2.37137370566165321e-04, 2.05352502645714556e-04,
1.77827941003892026e-04, 1.53992652605949057e-04, 1.33352143216332368e-04, 1.15478198468945645e-04};

__device__ __forceinline__ unsigned f2bf(float f) { unsigned u = __builtin_bit_cast(unsigned, f); return (u + 0x7fffu + ((u >> 16) & 1u)) >> 16; }
__device__ __forceinline__ unsigned pk2(float lo, float hi) { return pg8::cvt_pk_bf16(lo, hi); }
__device__ __forceinline__ float bflo(unsigned w) { return __builtin_bit_cast(float, w << 16); }
__device__ __forceinline__ float bfhi(unsigned w) { return __builtin_bit_cast(float, w & 0xffff0000u); }
__device__ __forceinline__ float bf2f(bf16 b) { return __builtin_bit_cast(float, (unsigned)b << 16); }
__device__ __forceinline__ float wave_sum(float v) {
#pragma unroll
    for (int o = 1; o < 64; o <<= 1) v += __shfl_xor(v, o);
    return v;
}
__device__ __forceinline__ float log_gamma(int h) { return h == 0 ? -3.17486983145802981e-02f : h == 1 ? -1.57483569681391676e-02f : h == 2 ? -7.84317746102589260e-03f : -3.91389932113632866e-03f; }
#define LDS_WAIT() asm volatile("s_waitcnt lgkmcnt(0)" ::: "memory")

struct EpiZ {
    static constexpr bool PERM = true, AFTER_DRAIN = false;
    bf16* O; int ldc;
    __device__ __forceinline__ void operator()(const f32x4 (&acc)[2][2][4][2], const pg8::Unit& u, int wr, int wc, int fr, int fq) const {
        const int row0 = u.pm * 256 + wr * 64 + fr, col0 = u.pn * 256 + wc * 32 + 8 * fq;
#pragma unroll
        for (int ai = 0; ai < 2; ++ai)
#pragma unroll
            for (int m = 0; m < 4; ++m) { bf16* rowp = O + (size_t)(row0 + ai * 128 + m * 16) * ldc + col0;
#pragma unroll
                for (int bj = 0; bj < 2; ++bj) { const f32x4 v0 = acc[ai][bj][m][0], v1 = acc[ai][bj][m][1];
                    u32x4 w; w.x = pk2(v0[0], v0[1]); w.y = pk2(v0[2], v0[3]); w.z = pk2(v1[0], v1[1]); w.w = pk2(v1[2], v1[3]);
                    *(u32x4*)(rowp + bj * 128) = w; } }
    }
};
struct EpiUp {
    static constexpr bool PERM = true, AFTER_DRAIN = false;
    bf16* O; int ldc; const LAS float* rs; mutable int ord;
    __device__ __forceinline__ void operator()(const f32x4 (&acc)[2][2][4][2], const pg8::Unit& u, int wr, int wc, int fr, int fq) const {
        const int row0 = u.pm * 256 + wr * 64 + fr, col0 = u.pn * 256 + wc * 32 + 8 * fq;
        const LAS float* rt = rs + ord * 256 + wr * 64 + fr;
#pragma unroll
        for (int ai = 0; ai < 2; ++ai)
#pragma unroll
            for (int m = 0; m < 4; ++m) { bf16* rowp = O + (size_t)(row0 + ai * 128 + m * 16) * ldc + col0; const float r = rt[ai * 128 + m * 16];
#pragma unroll
                for (int bj = 0; bj < 2; ++bj) { f32x4 v0 = acc[ai][bj][m][0] * r, v1 = acc[ai][bj][m][1] * r;
#pragma unroll
                    for (int k = 0; k < 4; ++k) { const float a0 = fmaxf(v0[k], 0.f), a1 = fmaxf(v1[k], 0.f); v0[k] = a0 * a0; v1[k] = a1 * a1; }
                    u32x4 w; w.x = pk2(v0[0], v0[1]); w.y = pk2(v0[2], v0[3]); w.z = pk2(v1[0], v1[1]); w.w = pk2(v1[2], v1[3]);
                    *(u32x4*)(rowp + bj * 128) = w; } }
        ord = ord + 1;
    }
};
struct EpiRes {
    static constexpr bool PERM = false, AFTER_DRAIN = false;
    const float* res; const float* res2; float* out; bf16* hb; float* part;
    __device__ __forceinline__ void operator()(const f32x4 (&acc)[2][2][4][2], const pg8::Unit& u, int wr, int wc, int fr, int fq) const {
        const int row0 = u.pm * 256 + wr * 64 + fr, col0 = u.pn * 256 + wc * 32 + 4 * fq;
#pragma unroll
        for (int ai = 0; ai < 2; ++ai)
#pragma unroll
            for (int m = 0; m < 4; ++m) { const int row = row0 + ai * 128 + m * 16; const size_t off = (size_t)row * DM + col0; float ss = 0.f;
                const float* rp = res + off;
#pragma unroll
                for (int bj = 0; bj < 2; ++bj)
#pragma unroll
                    for (int n = 0; n < 2; ++n) { f32x4 v = acc[ai][bj][m][n];
                        { const f32x4 b = *(const f32x4*)(rp + bj * 128 + n * 16); v = v + b; *(f32x4*)(out + off + bj * 128 + n * 16) = v;
                            if (hb) { u32x2 w; w.x = pk2(v[0], v[1]); w.y = pk2(v[2], v[3]); *(u32x2*)(hb + off + bj * 128 + n * 16) = w; } }
                        ss += (v[0] * v[0] + v[1] * v[1]) + (v[2] * v[2] + v[3] * v[3]); }
                ss += __shfl_xor(ss, 16); ss += __shfl_xor(ss, 32);
                if (fq == 0) part[(size_t)row * 16 + u.pn * 4 + wc] = ss;
                if (m & 1) asm volatile("" ::: "memory"); }
    }
};

__device__ __forceinline__ void transpose_item(const float* W, int K, int N, bf16* WT, LAS float* scr, int item, int lane, const float* ks) {
    const int nblk = N / 32, kb = item / nblk, nb = item % nblk, k0 = 64 * kb, n0 = 32 * nb;
#pragma unroll 8
    for (int i = 0; i < 32; ++i) { const int kk = 2 * i + (lane >> 5); float v = W[(size_t)(k0 + kk) * N + n0 + (lane & 31)]; if (ks) v *= ks[k0 + kk]; scr[kk * 33 + (lane & 31)] = v; }
    LDS_WAIT();
    const int c = lane & 7;
#pragma unroll
    for (int j = 0; j < 4; ++j) { const int n = (lane >> 3) + 8 * j; const LAS float* s = scr + (8 * c) * 33 + n;
        u32x4 o; o.x = pk2(s[0 * 33], s[1 * 33]); o.y = pk2(s[2 * 33], s[3 * 33]); o.z = pk2(s[4 * 33], s[5 * 33]); o.w = pk2(s[6 * 33], s[7 * 33]);
        *(u32x4*)(WT + (size_t)(n0 + n) * K + k0 + 8 * c) = o; }
    LDS_WAIT();
}
__device__ __forceinline__ void rms_row_to_bf16(const float* xrow, const float* g, bf16* orow, int lane) {
    unsigned long long* o8 = (unsigned long long*)orow + lane;
    if (!xrow) {
#pragma unroll
        for (int j = 0; j < 4; ++j) o8[64 * j] = 0ull;
        return; }
    const f32x4* xr = (const f32x4*)xrow + lane; const f32x4* gr = (const f32x4*)g + lane;
    f32x4 v[4]; float s = 0.f;
#pragma unroll
    for (int j = 0; j < 4; ++j) { v[j] = xr[64 * j]; s += (v[j].x * v[j].x + v[j].y * v[j].y) + (v[j].z * v[j].z + v[j].w * v[j].w); }
    const float rstd = 1.f / sqrtf(wave_sum(s) * (1.f / DM) + EPS);
#pragma unroll
    for (int j = 0; j < 4; ++j) { const f32x4 gg = gr[64 * j]; const f32x4 y = v[j] * rstd * gg;
        o8[64 * j] = (unsigned long long)pk2(y.x, y.y) | ((unsigned long long)pk2(y.z, y.w) << 32); }
}
__device__ __forceinline__ void rope_entry(int pos, int i, float& c, float& s) {
    const double ang = (double)pos * INVF[i];
    const double q = __builtin_rint(ang * 6.36619772367581382e-01);
    double r = __builtin_fma(-q, 1.57079632679489656e+00, ang); r = __builtin_fma(-q, 6.12323399573676604e-17, r);
    const double r2 = r * r;
    double sp = 1.0 / 6227020800.0; sp = sp * r2 - 1.0 / 39916800.0; sp = sp * r2 + 1.0 / 362880.0; sp = sp * r2 - 1.0 / 5040.0; sp = sp * r2 + 1.0 / 120.0; sp = sp * r2 - 1.0 / 6.0; sp = sp * r2 + 1.0; sp = sp * r;
    double cp = 1.0 / 479001600.0; cp = cp * r2 - 1.0 / 3628800.0; cp = cp * r2 + 1.0 / 40320.0; cp = cp * r2 - 1.0 / 720.0; cp = cp * r2 + 1.0 / 24.0; cp = cp * r2 - 0.5; cp = cp * r2 + 1.0;
    const int qi = (int)((long long)q & 3);
    const double sv = (qi == 0) ? sp : (qi == 1) ? cp : (qi == 2) ? -sp : -cp;
    const double cv = (qi == 0) ? cp : (qi == 1) ? -sp : (qi == 2) ? -cp : sp;
    c = (float)cv; s = (float)sv;
}

constexpr int LP = 136;
constexpr int T_BYTES = 128 * LP * 2;
__device__ __forceinline__ void stage_vt(LAS bf16* VT, const bf16* Z, int rowbase, int L, int h, int tid) {
    const int j = tid >> 2, q4 = tid & 3; const bool valid = j < L;
    const bf16* vp = Z + (size_t)(rowbase + j) * INW + ZC_V + h * HD + q4 * 32;
#pragma unroll
    for (int c = 0; c < 4; ++c) { u32x4 w = valid ? *(const u32x4*)(vp + c * 8) : (u32x4){0u, 0u, 0u, 0u};
#pragma unroll
        for (int k = 0; k < 4; ++k) { const int e = q4 * 32 + c * 8 + 2 * k; VT[e * LP + j] = (bf16)(w[k] & 0xffffu); VT[(e + 1) * LP + j] = (bf16)(w[k] >> 16); } }
}
__device__ __forceinline__ void load_krot(const bf16* Z, const float* COS, const float* SIN, int rowbase, int posbase, int j, int q4, int h, float sc, float (&lo)[16], float (&hi)[16]) {
    const bf16* kp = Z + (size_t)(rowbase + j) * INW + ZC_K + h * HD + q4 * 16;
    const float* cp = COS + (size_t)(posbase + j) * 64 + q4 * 16; const float* sp = SIN + (size_t)(posbase + j) * 64 + q4 * 16;
#pragma unroll
    for (int c = 0; c < 2; ++c) { const u32x4 a = *(const u32x4*)(kp + c * 8), b = *(const u32x4*)(kp + 64 + c * 8);
#pragma unroll
        for (int k = 0; k < 4; ++k) { const f32x4 cc = *(const f32x4*)(cp + c * 8 + (k >> 1) * 4), ss = *(const f32x4*)(sp + c * 8 + (k >> 1) * 4);
            const float x1a = bflo(a[k]), x1b = bfhi(a[k]), x2a = bflo(b[k]), x2b = bfhi(b[k]);
            const float c0 = cc[(k & 1) * 2], c1 = cc[(k & 1) * 2 + 1], s0 = ss[(k & 1) * 2], s1 = ss[(k & 1) * 2 + 1];
            lo[c * 8 + 2 * k] = (x1a * c0 - x2a * s0) * sc; lo[c * 8 + 2 * k + 1] = (x1b * c1 - x2b * s1) * sc;
            hi[c * 8 + 2 * k] = (x1a * s0 + x2a * c0) * sc; hi[c * 8 + 2 * k + 1] = (x1b * s1 + x2b * c1) * sc; } }
}

__device__ __forceinline__ void kv_unit(LAS unsigned char* lds, const bf16* Z, const float* COS, const float* SIN, int rowbase, int posbase, int L, int h, float* outp, int tid, int wave, int lane) {
    LAS bf16* KT = (LAS bf16*)lds; LAS bf16* VT = (LAS bf16*)(lds + T_BYTES);
    const float lg = log_gamma(h);
    { const int j = tid >> 2, q4 = tid & 3;
      if (j < L) { float lo[16], hi[16]; const float sc = 0.08838834764831845f * __expf((float)(L - 1 - j) * lg);
          load_krot(Z, COS, SIN, rowbase, posbase, j, q4, h, sc, lo, hi);
#pragma unroll
          for (int d = 0; d < 16; ++d) { KT[(q4 * 16 + d) * LP + j] = (bf16)f2bf(lo[d]); KT[(64 + q4 * 16 + d) * LP + j] = (bf16)f2bf(hi[d]); }
      } else {
#pragma unroll
          for (int d = 0; d < 16; ++d) { KT[(q4 * 16 + d) * LP + j] = 0; KT[(64 + q4 * 16 + d) * LP + j] = 0; } }
      stage_vt(VT, Z, rowbase, L, h, tid); }
    __syncthreads();
    const int fr = lane & 15, fq = lane >> 4;
    f32x4 acc[8];
#pragma unroll
    for (int n = 0; n < 8; ++n) acc[n] = (f32x4){0.f, 0.f, 0.f, 0.f};
#pragma unroll
    for (int ks = 0; ks < 4; ++ks) { const bf16x8 a = *(const LAS bf16x8*)(KT + (16 * wave + fr) * LP + ks * 32 + fq * 8);
#pragma unroll
        for (int n = 0; n < 8; ++n) { const bf16x8 b = *(const LAS bf16x8*)(VT + (16 * n + fr) * LP + ks * 32 + fq * 8);
            acc[n] = __builtin_amdgcn_mfma_f32_16x16x32_bf16(a, b, acc[n], 0, 0, 0); } }
#pragma unroll
    for (int n = 0; n < 8; ++n) *(f32x4*)(outp + (size_t)(16 * n + fr) * HD + 16 * wave + 4 * fq) = acc[n];
    __syncthreads();
}

__device__ __forceinline__ void ret_unit(LAS unsigned char* lds, const bf16* Z, const float* COS, const float* SIN, const bf16* STg, bf16* YMIX, int rowbase, int posbase, int h, int tid, int wave, int lane) {
    LAS bf16* KR = (LAS bf16*)lds; LAS bf16* VT = (LAS bf16*)(lds + T_BYTES); LAS bf16* STL = (LAS bf16*)(lds + 2 * T_BYTES);
    LAS bf16* PW = (LAS bf16*)(lds + 3 * T_BYTES) + wave * 16 * LP;
    const float lg = log_gamma(h);
    { const int j = tid >> 2, q4 = tid & 3; float lo[16], hi[16];
      load_krot(Z, COS, SIN, rowbase, posbase, j, q4, h, 0.08838834764831845f, lo, hi);
#pragma unroll
      for (int c = 0; c < 2; ++c) { u32x4 wl, wh;
#pragma unroll
          for (int k = 0; k < 4; ++k) { wl[k] = pk2(lo[c * 8 + 2 * k], lo[c * 8 + 2 * k + 1]); wh[k] = pk2(hi[c * 8 + 2 * k], hi[c * 8 + 2 * k + 1]); }
          *(LAS u32x4*)(KR + j * LP + q4 * 16 + c * 8) = wl; *(LAS u32x4*)(KR + j * LP + 64 + q4 * 16 + c * 8) = wh; }
      stage_vt(VT, Z, rowbase, 128, h, tid);
#pragma unroll
      for (int i = 0; i < 4; ++i) { const int idx = tid + 512 * i, e = idx >> 4, dc = idx & 15; *(LAS u32x4*)(STL + e * LP + dc * 8) = *(const u32x4*)(STg + (size_t)e * HD + dc * 8); } }
    const int fr = lane & 15, fq = lane >> 4;
    bf16x8 Qa[4], Qd[4];
    { const int i = 16 * wave + fr; const bf16* qp = Z + (size_t)(rowbase + i) * INW + ZC_Q + h * HD + fq * 8;
      const float* cp = COS + (size_t)(posbase + i) * 64 + fq * 8; const float* sp = SIN + (size_t)(posbase + i) * 64 + fq * 8;
      const float qdec = __expf((float)(i + 1) * lg);
#pragma unroll
      for (int kk = 0; kk < 2; ++kk) { const u32x4 a = *(const u32x4*)(qp + kk * 32), b = *(const u32x4*)(qp + 64 + kk * 32);
          const f32x4 c0 = *(const f32x4*)(cp + kk * 32), c1 = *(const f32x4*)(cp + kk * 32 + 4), s0 = *(const f32x4*)(sp + kk * 32), s1 = *(const f32x4*)(sp + kk * 32 + 4);
          u32x4 r1, r2, d1, d2;
#pragma unroll
          for (int k = 0; k < 4; ++k) { const float x1a = bflo(a[k]), x1b = bfhi(a[k]), x2a = bflo(b[k]), x2b = bfhi(b[k]);
              const float ca = (k < 2) ? c0[2 * k] : c1[2 * k - 4], cb = (k < 2) ? c0[2 * k + 1] : c1[2 * k - 3], sa = (k < 2) ? s0[2 * k] : s1[2 * k - 4], sb = (k < 2) ? s0[2 * k + 1] : s1[2 * k - 3];
              const float ya = x1a * ca - x2a * sa, yb = x1b * cb - x2b * sb, za = x1a * sa + x2a * ca, zb = x1b * sb + x2b * cb;
              r1[k] = pk2(ya, yb); r2[k] = pk2(za, zb); d1[k] = pk2(ya * qdec, yb * qdec); d2[k] = pk2(za * qdec, zb * qdec); }
          Qa[kk] = __builtin_bit_cast(bf16x8, r1); Qa[kk + 2] = __builtin_bit_cast(bf16x8, r2); Qd[kk] = __builtin_bit_cast(bf16x8, d1); Qd[kk + 2] = __builtin_bit_cast(bf16x8, d2); } }
    __syncthreads();
    const float lg2 = lg * 1.4426950408889634f;
    for (int jt = 0; jt <= wave; ++jt) { f32x4 s = (f32x4){0.f, 0.f, 0.f, 0.f};
#pragma unroll
        for (int ks = 0; ks < 4; ++ks) { const bf16x8 kf = *(const LAS bf16x8*)(KR + (16 * jt + fr) * LP + ks * 32 + fq * 8); s = __builtin_amdgcn_mfma_f32_16x16x32_bf16(Qa[ks], kf, s, 0, 0, 0); }
#pragma unroll
        for (int r = 0; r < 4; ++r) { const int dif = (16 * wave + 4 * fq + r) - (16 * jt + fr); const float v = dif >= 0 ? s[r] * __builtin_amdgcn_exp2f((float)dif * lg2) : 0.f;
            PW[(4 * fq + r) * LP + 16 * jt + fr] = (bf16)f2bf(v); } }
    if (!(wave & 1)) {
#pragma unroll
        for (int r = 0; r < 4; ++r) PW[(4 * fq + r) * LP + 16 * (wave + 1) + fr] = 0; }
    LDS_WAIT();
    f32x4 acc[8];
#pragma unroll
    for (int n = 0; n < 8; ++n) acc[n] = (f32x4){0.f, 0.f, 0.f, 0.f};
    const int nks = (wave >> 1) + 1;
    for (int ks = 0; ks < nks; ++ks) { const bf16x8 pf = *(const LAS bf16x8*)(PW + fr * LP + ks * 32 + fq * 8);
#pragma unroll
        for (int n = 0; n < 8; ++n) { const bf16x8 vf = *(const LAS bf16x8*)(VT + (16 * n + fr) * LP + ks * 32 + fq * 8); acc[n] = __builtin_amdgcn_mfma_f32_16x16x32_bf16(pf, vf, acc[n], 0, 0, 0); } }
#pragma unroll
    for (int ks = 0; ks < 4; ++ks) {
#pragma unroll
        for (int n = 0; n < 8; ++n) { const bf16x8 sf = *(const LAS bf16x8*)(STL + (16 * n + fr) * LP + ks * 32 + fq * 8); acc[n] = __builtin_amdgcn_mfma_f32_16x16x32_bf16(Qd[ks], sf, acc[n], 0, 0, 0); } }
#pragma unroll
    for (int r = 0; r < 4; ++r) { float ss = 0.f;
#pragma unroll
        for (int n = 0; n < 8; ++n) ss += acc[n][r] * acc[n][r];
        ss += __shfl_xor(ss, 1); ss += __shfl_xor(ss, 2); ss += __shfl_xor(ss, 4); ss += __shfl_xor(ss, 8);
        const float rstd = 1.f / sqrtf(ss * (1.f / HD) + EPS);
        const size_t row = (size_t)(rowbase + 16 * wave + 4 * fq + r);
        const bf16* gp = Z + row * INW + ZC_G + h * HD + fr; bf16* yp = YMIX + row * DM + 512 + h * HD + fr;
#pragma unroll
        for (int n = 0; n < 8; ++n) { const float g = bf2f(gp[16 * n]); const float y = acc[n][r] * rstd * (g / (1.f + __expf(-g))); yp[16 * n] = (bf16)f2bf(y); } }
    __syncthreads();
}


template <int KLEN> __device__ __forceinline__ f32x4 mini16(const bf16* A, int lda, const bf16* Bt, int ldb, int n0, int k0, int wave, int fr, int fq) {
    const bf16* ap = A + (size_t)(16 * wave + fr) * lda + k0 + fq * 8; const bf16* bp = Bt + (size_t)(n0 + fr) * ldb + k0 + fq * 8;
    f32x4 acc = (f32x4){0.f, 0.f, 0.f, 0.f};
#pragma unroll 16
    for (int ks = 0; ks < KLEN / 32; ++ks) { const bf16x8 av = *(const bf16x8*)(ap + ks * 32), bv = *(const bf16x8*)(bp + ks * 32);
        acc = __builtin_amdgcn_mfma_f32_16x16x32_bf16(av, bv, acc, 0, 0, 0); }
    return acc;
}

#define XB_TMO      128
#define XB_XCNT(j)  (256  + 64 * (j))
#define XB_XSUB(j)  (1280 + 64 * (j))
#define XB_XGEN(j)  (2304 + 64 * (j))
#define XB_TOP      3328
#define XB_TOPGEN   3392
#define XCD_BAR_WORDS 3456
#define XB_SPIN_CAP (1u << 18)

__device__ __forceinline__ unsigned xb_ld(unsigned* p)              { return __hip_atomic_load(p, __ATOMIC_RELAXED, __HIP_MEMORY_SCOPE_AGENT); }
__device__ __forceinline__ unsigned xb_add(unsigned* p, unsigned v) { return __hip_atomic_fetch_add(p, v, __ATOMIC_RELAXED, __HIP_MEMORY_SCOPE_AGENT); }
__device__ __forceinline__ unsigned xb_xcc_id() { return (unsigned)__builtin_amdgcn_s_getreg((3 << 11) | 20) & 0xFu; }
#define XB_SPIN(cond, bar) do { unsigned _sp = 0; while (cond) { __builtin_amdgcn_s_sleep(1); \
    if ((++_sp & 255u) == 0u) { if (xb_ld(&(bar)[XB_TMO])) break; if (_sp > XB_SPIN_CAP) { atomicAdd(&(bar)[XB_TMO], 1u); break; } } } } while (0)

struct XcdBarrier {
    unsigned* bar; unsigned x;
    volatile LAS unsigned* st;
};

__device__ __forceinline__ XcdBarrier xcd_barrier_post(unsigned* bar, volatile LAS unsigned* st) {
    XcdBarrier b; b.bar = bar; b.x = xb_xcc_id(); b.st = st;
    if (threadIdx.x == 0) (void)xb_add(&bar[XB_XCNT(b.x)], 1u);
    return b;
}
__device__ __forceinline__ void xcd_barrier_complete(unsigned* bar, unsigned x, unsigned& nloc, unsigned& nx) {
    const unsigned G = gridDim.x * gridDim.y * gridDim.z;
    unsigned sum, cnt, mine, sp = 0u;
    for (;;) {
        sum = 0u; cnt = 0u; mine = 0u;
#pragma unroll
        for (unsigned j = 0; j < 16; ++j) { const unsigned c = xb_ld(&bar[XB_XCNT(j)]); sum += c; cnt += (c > 0u) ? 1u : 0u; mine = (j == x) ? c : mine; }
        if (sum == G) break;
        __builtin_amdgcn_s_sleep(1);
        if ((++sp & 255u) == 0u) { if (xb_ld(&bar[XB_TMO])) break; if (sp > XB_SPIN_CAP) { atomicAdd(&bar[XB_TMO], 1u); break; } }
    }
    nloc = mine > 0u ? mine : 1u; nx = cnt > 0u ? cnt : 1u;
}

__device__ __forceinline__ void xcd_barrier(const XcdBarrier& b) {
    asm volatile("s_waitcnt vmcnt(0)" ::: "memory");
    __syncthreads();
    if (threadIdx.x == 0) {
        unsigned* bar = b.bar;
        __builtin_amdgcn_s_waitcnt(0);
        unsigned nloc = b.st[0], nx = b.st[1];
        if (nloc == 0u) { xcd_barrier_complete(bar, b.x, nloc, nx); b.st[0] = nloc; b.st[1] = nx; }
        const unsigned old = xb_add(&bar[XB_XSUB(b.x)], 1u);
        const unsigned gen = old / nloc;
        if (old + 1u == (gen + 1u) * nloc) {
            __builtin_amdgcn_fence(__ATOMIC_RELEASE, "agent");
            asm volatile("s_waitcnt vmcnt(0)" ::: "memory");
            const unsigned og = xb_add(&bar[XB_TOP], 1u);
            const unsigned tg = og / nx;
            if (og + 1u == (tg + 1u) * nx) xb_add(&bar[XB_TOPGEN], 1u);
            else XB_SPIN(xb_ld(&bar[XB_TOPGEN]) == tg, bar);
            __builtin_amdgcn_fence(__ATOMIC_ACQUIRE, "agent");
            xb_add(&bar[XB_XGEN(b.x)], 1u);
            asm volatile("s_waitcnt vmcnt(0)" ::: "memory");
        } else {
            XB_SPIN(xb_ld(&bar[XB_XGEN(b.x)]) == gen, bar);
            __builtin_amdgcn_fence(__ATOMIC_ACQUIRE, "agent");
            asm volatile("s_waitcnt vmcnt(0)" ::: "memory");
        }
    }
    __syncthreads();
}

struct Args { const float* in[13]; float* out; unsigned char* ws; };
__global__ void __launch_bounds__(512, 2) hymba_fwd(Args a) {
    extern __shared__ __attribute__((aligned(16))) unsigned char lds_raw[];
    LAS unsigned char* lds = (LAS unsigned char*)lds_raw;
    cg::grid_group grid = cg::this_grid();
    const int tid = threadIdx.x, lane = tid & 63, wave = __builtin_amdgcn_readfirstlane(tid >> 6);
    const int G = gridDim.x, bid = blockIdx.x;
    const float* x_prompt = a.in[0]; const float* x_sample = a.in[1]; const float* cache_conv = a.in[2]; const float* state_ret = a.in[3]; const float* meta = a.in[4];
    const float* norm_mix = a.in[5]; const float* w_in = a.in[6]; const float* conv_w = a.in[7]; const float* w_out = a.in[8]; const float* norm_mlp = a.in[9];
    const float* w_up = a.in[10]; const float* w_down = a.in[11]; const float* norm_final = a.in[12];
    float* out = a.out; unsigned char* ws = a.ws;
    float* PART1 = (float*)(ws + WS_PART1); float* PART2 = (float*)(ws + WS_PART2);
    bf16* W1t = (bf16*)(ws + WS_W1); bf16* W2t = (bf16*)(ws + WS_W2); bf16* W3t = (bf16*)(ws + WS_W3); bf16* W4t = (bf16*)(ws + WS_W4);
    bf16* XN = (bf16*)(ws + WS_XN); bf16* STb = (bf16*)(ws + WS_ST); bf16* H1B = (bf16*)(ws + WS_H1B);
    bf16* Z = (bf16*)(ws + WS_Z); bf16* YMIX = (bf16*)(ws + WS_YMIX); bf16* HID = (bf16*)(ws + WS_HID);
    float* KV = (float*)(ws + WS_KV); float* KVM = (float*)(ws + WS_KVM); float* COS = (float*)(ws + WS_COS); float* SIN = (float*)(ws + WS_SIN);
    bf16* HIDS = (bf16*)(ws + WS_HIDS); float* PARTS1 = (float*)(ws + WS_PARTS1); float* SPART = (float*)(ws + WS_SPART);
    const int gw = bid * 8 + wave, NGW = G * 8;
    if (a.ws == nullptr) grid.sync();
    volatile LAS unsigned* bst = (volatile LAS unsigned*)(lds + LDS_BYTES - 64);
    if (tid < 16) bst[tid] = 0u;
    __syncthreads();
    const XcdBarrier xbar = xcd_barrier_post((unsigned*)(ws + WS_CTL), bst);
#define GRID_SYNC() xcd_barrier(xbar)

for (int rep_ = 0; rep_ < REP_P0; ++rep_) {
    {
        LAS float* scr = (LAS float*)(lds + wave * 16384);
        constexpr int I1 = (DM / 64) * (INW / 32), I2 = (DM / 64) * (DM / 32), I3 = (DM / 64) * (FF / 32), I4 = (FF / 64) * (DM / 32);
        for (int it = gw; it < I1 + I2 + I3 + I4; it += NGW) {
            int r = it;
            if (r < I1) { transpose_item(w_in, DM, INW, W1t, scr, r, lane, nullptr); continue; } r -= I1;
            if (r < I2) { transpose_item(w_out, DM, DM, W2t, scr, r, lane, nullptr); continue; } r -= I2;
            if (r < I3) { transpose_item(w_up, DM, FF, W3t, scr, r, lane, norm_mlp); continue; } r -= I3;
            transpose_item(w_down, FF, DM, W4t, scr, r, lane, nullptr);
        }
        for (int m = gw; m < MPAD; m += NGW) {
            const float* xr = m < MP ? x_prompt + (size_t)m * DM : m < ROW_M ? x_sample + (size_t)(m - ROW_S) * DM : m < ROW_M + 16 ? meta + (size_t)(m - ROW_M) * DM : nullptr;
            rms_row_to_bf16(xr, norm_mix, XN + (size_t)m * DM, lane);
        }
        for (int idx = bid * 512 + tid; idx < NPOS * 64; idx += G * 512) { const int p = idx >> 6, i = idx & 63; float c, s; rope_entry(p < 2064 ? p : 16384, i, c, s); COS[idx] = c; SIN[idx] = s; }
    }
}
for (int rep_ = 1; rep_ < REP_SYNC; ++rep_) GRID_SYNC();
    GRID_SYNC();

    { pg8::Gemm g{XN, W1t, MPAD, INW, DM}; pg8::StaticOrder S; S.init(MPAD, INW, G, bid); EpiZ E{Z, INW};
      pg8::gemm_phase<EpiZ, pg8::StaticOrder, true, PG8_SP2>(lds, g, S, E); }
    GRID_SYNC();

for (int rep_ = 0; rep_ < REP_KV; ++rep_) {
    for (int u = bid; u < 4 + NB * NH * NCH; u += G) {
        if (u < 4) kv_unit(lds, Z, COS, SIN, ROW_M, 0, 16, u, KVM + (size_t)u * HD * HD, tid, wave, lane);
        else { const int uu = u - 4, c = uu & 15, h = (uu >> 4) & 3, b = uu >> 6;
            kv_unit(lds, Z, COS, SIN, b * SEQ + c * 128, 16 + c * 128, 128, h, KV + (size_t)uu * HD * HD, tid, wave, lane); }
    }
}
for (int rep_ = 0; rep_ < REP_CONV; ++rep_) {
    for (int it = bid; it < MP / 64; it += G) {
        const int tg = tid >> 6, c8 = (tid & 63) * 8, t0 = it * 64 + tg * 8, tin = t0 & (SEQ - 1), b = t0 >> 11;
        const int rm2 = tin == 0 ? ROW_M + 14 : t0 - 2, rm1 = tin == 0 ? ROW_M + 15 : t0 - 1;
        float w0[8], w1[8], w2[8], p2[8], p1[8];
#pragma unroll
        for (int k = 0; k < 8; ++k) { w0[k] = conv_w[c8 + k]; w1[k] = conv_w[512 + c8 + k]; w2[k] = conv_w[1024 + c8 + k]; }
        { const u32x4 ua = *(const u32x4*)(Z + (size_t)rm2 * INW + ZC_U + c8), ca = *(const u32x4*)(Z + (size_t)rm2 * INW + ZC_C + c8);
          const u32x4 ub = *(const u32x4*)(Z + (size_t)rm1 * INW + ZC_U + c8), cb = *(const u32x4*)(Z + (size_t)rm1 * INW + ZC_C + c8);
#pragma unroll
          for (int k = 0; k < 4; ++k) { p2[2 * k] = bflo(ua[k]) * bflo(ca[k]); p2[2 * k + 1] = bfhi(ua[k]) * bfhi(ca[k]); p1[2 * k] = bflo(ub[k]) * bflo(cb[k]); p1[2 * k + 1] = bfhi(ub[k]) * bfhi(cb[k]); } }
        for (int k8 = 0; k8 < 8; ++k8) { const size_t row = (size_t)(t0 + k8);
            const u32x4 uu = *(const u32x4*)(Z + row * INW + ZC_U + c8), cc = *(const u32x4*)(Z + row * INW + ZC_C + c8), bb = *(const u32x4*)(Z + row * INW + ZC_B + c8);
            float cu[8], y[8];
#pragma unroll
            for (int k = 0; k < 4; ++k) { cu[2 * k] = bflo(uu[k]) * bflo(cc[k]); cu[2 * k + 1] = bfhi(uu[k]) * bfhi(cc[k]); }
#pragma unroll
            for (int k = 0; k < 4; ++k) { y[2 * k] = bflo(bb[k]) * (w0[2 * k] * p2[2 * k] + w1[2 * k] * p1[2 * k] + w2[2 * k] * cu[2 * k]);
                y[2 * k + 1] = bfhi(bb[k]) * (w0[2 * k + 1] * p2[2 * k + 1] + w1[2 * k + 1] * p1[2 * k + 1] + w2[2 * k + 1] * cu[2 * k + 1]); }
            u32x4 yo; yo.x = pk2(y[0], y[1]); yo.y = pk2(y[2], y[3]); yo.z = pk2(y[4], y[5]); yo.w = pk2(y[6], y[7]);
            *(u32x4*)(YMIX + row * DM + c8) = yo;
            if (tin + k8 >= SEQ - 2) { float* cp = out + O_CP + ((size_t)b * 2 + (tin + k8 - (SEQ - 2))) * 512 + c8;
                *(f32x4*)cp = (f32x4){cu[0], cu[1], cu[2], cu[3]}; *(f32x4*)(cp + 4) = (f32x4){cu[4], cu[5], cu[6], cu[7]}; }
#pragma unroll
            for (int k = 0; k < 8; ++k) { p2[k] = p1[k]; p1[k] = cu[k]; } }
    }
}
    for (int it = bid; it < NSAMP / 8; it += G) {
        const int b = it * 8 + (tid >> 6), c8 = (tid & 63) * 8; const size_t row = (size_t)(ROW_S + b);
        const u32x4 uu = *(const u32x4*)(Z + row * INW + ZC_U + c8), cc = *(const u32x4*)(Z + row * INW + ZC_C + c8), bb = *(const u32x4*)(Z + row * INW + ZC_B + c8);
        const float* pc = cache_conv + (size_t)b * 1024 + c8; float* nc = out + O_CS + (size_t)b * 1024 + c8;
        float cu[8], y[8], p2[8], p1[8];
#pragma unroll
        for (int k = 0; k < 8; ++k) { p2[k] = pc[k]; p1[k] = pc[512 + k]; }
#pragma unroll
        for (int k = 0; k < 4; ++k) { cu[2 * k] = bflo(uu[k]) * bflo(cc[k]); cu[2 * k + 1] = bfhi(uu[k]) * bfhi(cc[k]); }
#pragma unroll
        for (int k = 0; k < 8; ++k) { const float bg = (k & 1) ? bfhi(bb[k >> 1]) : bflo(bb[k >> 1]);
            y[k] = bg * (conv_w[c8 + k] * p2[k] + conv_w[512 + c8 + k] * p1[k] + conv_w[1024 + c8 + k] * cu[k]); nc[k] = p1[k]; nc[512 + k] = cu[k]; }
        u32x4 yo; yo.x = pk2(y[0], y[1]); yo.y = pk2(y[2], y[3]); yo.z = pk2(y[4], y[5]); yo.w = pk2(y[6], y[7]);
        *(u32x4*)(YMIX + row * DM + c8) = yo;
    }
for (int rep_ = 0; rep_ < REP_SRET; ++rep_) {
    for (int it = bid; it < NSAMP * NH; it += G) {
        const int b = it >> 2, h = it & 3; const size_t row = (size_t)(ROW_S + b);
        LAS float* sq = (LAS float*)lds; LAS float* sk = sq + 128; LAS float* sv = sq + 256; LAS float* red = sq + 384; LAS float* tot = sq + 384 + 16 * 128;
        if (tid < 128) { const int d = tid, dd = d & 63; const float c = COS[2064 * 64 + dd], s = SIN[2064 * 64 + dd];
            const bf16* zr = Z + row * INW + h * HD;
            const float q1 = bf2f(zr[ZC_Q + dd]), q2 = bf2f(zr[ZC_Q + dd + 64]), k1 = bf2f(zr[ZC_K + dd]), k2 = bf2f(zr[ZC_K + dd + 64]);
            sq[d] = d < 64 ? q1 * c - q2 * s : q1 * s + q2 * c; sk[d] = (d < 64 ? k1 * c - k2 * s : k1 * s + k2 * c) * 0.08838834764831845f; sv[d] = bf2f(zr[ZC_V + d]); }
        __syncthreads();
        const float gam = 1.0f - 1.0f / (float)(32 << h);
        const int e4 = tid & 31, dg = tid >> 5;
        const float* sp = state_ret + ((size_t)(b * NH + h) * HD) * HD + e4 * 4; float* np = out + O_RS + ((size_t)(b * NH + h) * HD) * HD + e4 * 4;
        const f32x4 vv = *(const LAS f32x4*)(sv + e4 * 4); f32x4 o = (f32x4){0.f, 0.f, 0.f, 0.f};
#pragma unroll
        for (int i2 = 0; i2 < 8; ++i2) { const int d = dg * 8 + i2; const f32x4 S0 = *(const f32x4*)(sp + (size_t)d * HD); const f32x4 Sn = S0 * gam + vv * sk[d];
            *(f32x4*)(np + (size_t)d * HD) = Sn; o = o + Sn * sq[d]; }
        *(LAS f32x4*)(red + dg * 128 + e4 * 4) = o;
        __syncthreads();
        float oe = 0.f;
        if (tid < 128) {
#pragma unroll
            for (int g2 = 0; g2 < 16; ++g2) oe += red[g2 * 128 + tid];
            const float ss = wave_sum(oe * oe); if (lane == 0) tot[wave] = ss; }
        __syncthreads();
        if (tid < 128) { const float rstd = 1.f / sqrtf((tot[0] + tot[1]) * (1.f / HD) + EPS); const float g = bf2f(Z[row * INW + ZC_G + h * HD + tid]);
            YMIX[row * DM + 512 + h * HD + tid] = (bf16)f2bf(oe * rstd * (g / (1.f + __expf(-g)))); }
        __syncthreads();
    }
}
    GRID_SYNC();

for (int rep_ = 0; rep_ < REP_SCAN; ++rep_) {
    for (int it = bid; it < 256; it += G) {
        const int gid = it * 512 + tid, bh = gid >> 12, idx4 = gid & 4095, h = bh & 3; const size_t off = (size_t)idx4 * 4;
        const float gam = 1.0f - 1.0f / (float)(32 << h); float g128 = gam;
#pragma unroll
        for (int k = 0; k < 7; ++k) g128 *= g128;
        f32x4 s = *(const f32x4*)(KVM + (size_t)h * HD * HD + off);
        for (int c = 0; c < NCH; ++c) { const size_t ub = ((size_t)bh * NCH + c) * HD * HD + off;
            u32x2 w; w.x = pk2(s[0], s[1]); w.y = pk2(s[2], s[3]); *(u32x2*)(STb + ub) = w;
            const f32x4 kv = *(const f32x4*)(KV + ub); s = s * g128 + kv; }
        LAS float* T = (LAS float*)lds; const int el = tid >> 5, d0 = (tid & 31) * 4, e0 = (it & 7) * 16;
#pragma unroll
        for (int r = 0; r < 4; ++r) T[(d0 + r) * 17 + el] = s[r];
        __syncthreads();
        { const int d = tid >> 2, q = tid & 3; f32x4 o; o.x = T[d * 17 + q * 4]; o.y = T[d * 17 + q * 4 + 1]; o.z = T[d * 17 + q * 4 + 2]; o.w = T[d * 17 + q * 4 + 3];
          *(f32x4*)(out + O_RP + ((size_t)bh * HD + d) * HD + e0 + q * 4) = o; }
        __syncthreads();
    }
}
for (int rep_ = 0; rep_ < REP_S2; ++rep_) {
    if (bid < 64) {
        const int fr = lane & 15, fq = lane >> 4, n0 = bid * 16;
        const f32x4 acc = mini16<DM>(YMIX + (size_t)ROW_S * DM, DM, W2t, DM, n0, 0, wave, fr, fq);
#pragma unroll
        for (int r = 0; r < 4; ++r) { const int row = 16 * wave + 4 * fq + r; const size_t o = (size_t)row * DM + n0 + fr;
            const float v = acc[r] + x_sample[o]; out[O_YS + o] = v; H1B[(size_t)ROW_S * DM + o] = (bf16)f2bf(v); float ss = v * v;
            ss += __shfl_xor(ss, 1); ss += __shfl_xor(ss, 2); ss += __shfl_xor(ss, 4); ss += __shfl_xor(ss, 8);
            if (fr == 0) PARTS1[row * 64 + bid] = ss; }
    }
}
    GRID_SYNC();

for (int rep_ = 0; rep_ < REP_RET; ++rep_) {
    for (int u = bid; u < NB * NH * NCH; u += G) { const int c = u & 15, h = (u >> 4) & 3, b = u >> 6;
        ret_unit(lds, Z, COS, SIN, STb + (size_t)u * HD * HD, YMIX, b * SEQ + c * 128, 16 + c * 128, h, tid, wave, lane); }
}
for (int rep_ = 0; rep_ < REP_S3; ++rep_) {
    for (int it = bid; it < 256; it += G) {
        const int fr = lane & 15, fq = lane >> 4, n0 = it * 16;
        float rstdv; { const f32x4* p = (const f32x4*)(PARTS1 + (16 * wave + (lane >> 2)) * 64 + (lane & 3) * 16); const f32x4 a0 = p[0], a1 = p[1], a2 = p[2], a3 = p[3];
            float ss = (((a0[0] + a0[1]) + (a0[2] + a0[3])) + ((a1[0] + a1[1]) + (a1[2] + a1[3]))) + (((a2[0] + a2[1]) + (a2[2] + a2[3])) + ((a3[0] + a3[1]) + (a3[2] + a3[3])));
            ss += __shfl_xor(ss, 1); ss += __shfl_xor(ss, 2); rstdv = 1.f / sqrtf(ss * (1.f / DM) + EPS); }
        const f32x4 acc = mini16<DM>(H1B + (size_t)ROW_S * DM, DM, W3t, DM, n0, 0, wave, fr, fq);
#pragma unroll
        for (int r = 0; r < 4; ++r) { const int row = 16 * wave + 4 * fq + r; const float rs = __shfl(rstdv, (4 * fq + r) * 4);
            const float v = fmaxf(acc[r] * rs, 0.f); HIDS[(size_t)row * FF + n0 + fr] = (bf16)f2bf(v * v); }
    }
}
    GRID_SYNC();

    for (int rep_ = 0; rep_ < REP_S4; ++rep_)
    for (int it = bid; it < 256; it += G) {
        const int fr = lane & 15, fq = lane >> 4, n0 = (it & 63) * 16, kq = it >> 6;
        const f32x4 acc = mini16<DM>(HIDS, FF, W4t, FF, n0, kq * DM, wave, fr, fq);
#pragma unroll
        for (int r = 0; r < 4; ++r) SPART[((size_t)kq * NSAMP + 16 * wave + 4 * fq + r) * DM + n0 + fr] = acc[r];
    }
    { pg8::Gemm g{YMIX, W2t, MP, DM, DM}; pg8::StaticOrder S; S.init(MP, DM, G, bid); EpiRes E{x_prompt, x_sample, out, H1B, PART1};
      pg8::gemm_phase<EpiRes, pg8::StaticOrder, true, PG8_SP2>(lds, g, S, E); }
    GRID_SYNC();

    { pg8::Gemm g{H1B, W3t, MP, FF, DM}; pg8::StaticOrder S; S.init(MP, FF, G, bid);
      LAS float* rs = (LAS float*)(lds + RING_BYTES);
      for (int idx = tid; idx < 4 * 256; idx += 512) { pg8::Unit u; if (S.next(idx >> 8, u)) { const f32x4* p = (const f32x4*)(PART1 + (size_t)(u.pm * 256 + (idx & 255)) * 16);
              const f32x4 a0 = p[0], a1 = p[1], a2 = p[2], a3 = p[3]; const float ss = ((a0[0] + a0[1]) + (a0[2] + a0[3])) + ((a1[0] + a1[1]) + (a1[2] + a1[3])) + ((a2[0] + a2[1]) + (a2[2] + a2[3])) + ((a3[0] + a3[1]) + (a3[2] + a3[3]));
              rs[idx] = 1.f / sqrtf(ss * (1.f / DM) + EPS); } }
      __syncthreads();
      EpiUp E{HID, FF, rs, 0};
      pg8::gemm_phase<EpiUp, pg8::StaticOrder, true, PG8_SP2>(lds, g, S, E); }
    GRID_SYNC();

    { pg8::Gemm g{HID, W4t, MP, DM, FF}; pg8::StaticOrder S; S.init(MP, DM, G, bid); EpiRes E{out, out + (size_t)MP * DM, out, nullptr, PART2};
      pg8::gemm_phase<EpiRes, pg8::StaticOrder, true, PG8_SP2>(lds, g, S, E); }
    GRID_SYNC();

    for (int m = gw; m < MV; m += NGW) {
        f32x4* xr = (f32x4*)(out + (size_t)m * DM) + lane; const f32x4* gr = (const f32x4*)norm_final + lane;
        if (m < MP) {
            const float pv = lane < 16 ? PART2[(size_t)m * 16 + lane] : 0.f; const float rstd = 1.f / sqrtf(wave_sum(pv) * (1.f / DM) + EPS);
#pragma unroll
            for (int j = 0; j < 4; ++j) { const f32x4 v = xr[64 * j]; xr[64 * j] = v * rstd * gr[64 * j]; }
        } else {
            f32x4 v[4]; float ss = 0.f;
#pragma unroll
            for (int j = 0; j < 4; ++j) { v[j] = xr[64 * j];
#pragma unroll
                for (int q = 0; q < 4; ++q) v[j] = v[j] + ((const f32x4*)(SPART + ((size_t)q * NSAMP + (m - MP)) * DM) + lane)[64 * j];
                ss += (v[j].x * v[j].x + v[j].y * v[j].y) + (v[j].z * v[j].z + v[j].w * v[j].w); }
            const float rstd = 1.f / sqrtf(wave_sum(ss) * (1.f / DM) + EPS);
#pragma unroll
            for (int j = 0; j < 4; ++j) xr[64 * j] = v[j] * rstd * gr[64 * j];
        }
    }
}

extern "C" void kernel_launch(void* const* d_in, const int* in_sizes, int n_in, void* d_out, int out_size, void* d_ws, size_t ws_size, hipStream_t stream) {
    static int grid = 0;
    if (grid == 0) {
        if (n_in != 13 || ws_size < WS_END) { fprintf(stderr, "kernel_launch: unexpected n_in %d / ws_size %zu\n", n_in, ws_size); grid = -1; return; }
        int dev = 0, cus = 0, per_cu = 0;
        hipGetDevice(&dev); hipDeviceGetAttribute(&cus, hipDeviceAttributeMultiprocessorCount, dev);
        if (hipFuncSetAttribute((const void*)hymba_fwd, hipFuncAttributeMaxDynamicSharedMemorySize, LDS_BYTES) != hipSuccess) { fprintf(stderr, "kernel_launch: hipFuncSetAttribute failed\n"); grid = -1; return; }
        if (hipOccupancyMaxActiveBlocksPerMultiprocessor(&per_cu, (const void*)hymba_fwd, 512, LDS_BYTES) != hipSuccess || per_cu < 1) { fprintf(stderr, "kernel_launch: occupancy query says %d\n", per_cu); per_cu = 1; }
        (void)hipGetLastError();
        grid = cus * per_cu;
    }
    if (grid < 0) return;
    if (hipMemsetAsync((char*)d_ws + WS_CTL, 0, CTL_BYTES, stream) != hipSuccess) { fprintf(stderr, "kernel_launch: memset failed\n"); return; }
    Args a{};
    for (int i = 0; i < 13; ++i) a.in[i] = (const float*)d_in[i];
    a.out = (float*)d_out; a.ws = (unsigned char*)d_ws;
    void* args[] = {&a};
    hipError_t e = hipLaunchCooperativeKernel((const void*)hymba_fwd, dim3(grid), dim3(512), args, LDS_BYTES, stream);
    if (e != hipSuccess) fprintf(stderr, "cooperative launch failed: %s (grid %d)\n", hipGetErrorString(e), grid);
}
```
